# Optimizing an MI355X kernel written in HIP

```python
import math
import jax, jax.numpy as jnp
from jax import lax
import numpy as np

D_MODEL = 1024
BATCH = 4
SEQ = 8192
DEPTH = 4

HEAD_DIM = 64
N_RET_HEADS = 8
N_MOBA_HEADS = 8
RET_WIDTH = N_RET_HEADS * HEAD_DIM
MOBA_WIDTH = N_MOBA_HEADS * HEAD_DIM
RET_CHUNK = 128
MOBA_BLOCK = 256
MOBA_TOPK = 3
MOBA_Q_BLOCK = 64
GMLP_CHUNK = 128
GMLP_GROUPS = 8
GMLP_WIDTH = 2 * D_MODEL
FFN_HIDDEN = 4 * D_MODEL
ROPE_THETA = 10000.0
LN_EPS = 1e-5
N_EVEN = (DEPTH + 1) // 2
N_ODD = DEPTH // 2
DEEPNORM_ALPHA = (2 * DEPTH) ** 0.25
DEEPNORM_BETA = (8 * DEPTH) ** -0.25
IN_COLS = 4 * RET_WIDTH + 3 * MOBA_WIDTH
IN_SPLITS = [RET_WIDTH * i for i in range(1, 5)] + [4 * RET_WIDTH + MOBA_WIDTH * i for i in range(1, 3)]

kernel_name = "retnet_moba_gmlp_deepnorm_hybrid"


def layer_norm(x, g, b):
    xf = x.astype(jnp.float32)
    mu = jnp.mean(xf, -1, keepdims=True)
    var = jnp.mean(jnp.square(xf - mu), -1, keepdims=True)
    return ((xf - mu) * lax.rsqrt(var + LN_EPS) * g.astype(jnp.float32) + b.astype(jnp.float32)).astype(x.dtype)


def rope_tables(positions):
    inv_freq = ROPE_THETA ** (-jnp.arange(0, HEAD_DIM, 2, dtype=jnp.float32) / HEAD_DIM)
    ang = positions.astype(jnp.float32)[..., None] * inv_freq
    return jnp.cos(ang)[:, None], jnp.sin(ang)[:, None]


def apply_rope(t, cos, sin):
    half = HEAD_DIM // 2
    t1, t2 = t[..., :half], t[..., half:]
    return jnp.concatenate([t1 * cos - t2 * sin, t2 * cos + t1 * sin], -1).astype(t.dtype)


def split_heads(t, n_heads):
    b, s, _ = t.shape
    return t.reshape(b, s, n_heads, HEAD_DIM).transpose(0, 2, 1, 3)


def merge_heads(t):
    b, h, s, d = t.shape
    return t.transpose(0, 2, 1, 3).reshape(b, s, h * d)


def retention(q, k, v):
    b, h, s, d = q.shape
    n = s // RET_CHUNK
    dt = q.dtype
    log_gamma = jnp.log1p(-jnp.exp2(-5.0 - jnp.arange(h, dtype=jnp.float32)))
    idx = jnp.arange(RET_CHUNK, dtype=jnp.float32)
    diff = idx[:, None] - idx[None, :]
    decay = jnp.where(diff >= 0, jnp.exp(log_gamma[:, None, None] * jnp.maximum(diff, 0.0)), 0.0)
    xi = jnp.exp(log_gamma[:, None] * (idx + 1.0))
    zeta = jnp.exp(log_gamma[:, None] * (RET_CHUNK - 1.0 - idx))
    chunk_decay = jnp.exp(log_gamma * RET_CHUNK)
    qc = q.reshape(b, h, n, RET_CHUNK, d)
    kc = k.reshape(b, h, n, RET_CHUNK, d) * (d ** -0.5)
    vc = v.reshape(b, h, n, RET_CHUNK, d)
    scores = jnp.einsum('bhnid,bhnjd->bhnij', qc, kc) * decay[:, None].astype(dt)
    inner = jnp.einsum('bhnij,bhnjd->bhnid', scores, vc)
    kv = jnp.einsum('bhnjd,bhnje->nbhde', kc * zeta[:, None, :, None].astype(dt), vc).astype(jnp.float32)

    def step(state, kv_n):
        return state * chunk_decay[:, None, None] + kv_n, state

    _, states = lax.scan(step, jnp.zeros((b, h, d, d), jnp.float32), kv)
    cross = jnp.einsum('bhnid,nbhde->bhnie', qc, states.astype(dt)) * xi[:, None, :, None].astype(dt)
    return (inner + cross).reshape(b, h, s, d)


def moba_attention(q, k, v):
    b, h, s, d = q.shape
    nb = s // MOBA_BLOCK
    nq = s // MOBA_Q_BLOCK
    topk = min(MOBA_TOPK, nb)
    scale = d ** -0.5
    k_blocks = k.reshape(b, h, nb, MOBA_BLOCK, d)
    v_blocks = v.reshape(b, h, nb, MOBA_BLOCK, d)
    k_mean = jnp.mean(k_blocks.astype(jnp.float32), axis=3)
    q_chunks = jnp.moveaxis(q.reshape(b, h, nq, MOBA_Q_BLOCK, d), 2, 0)
    bi = jnp.arange(b)[:, None, None, None]
    hi = jnp.arange(h)[None, :, None, None]
    blk_ids = jnp.arange(nb)
    q_off = jnp.arange(MOBA_Q_BLOCK)
    k_off = jnp.arange(MOBA_BLOCK)
    n_sel = topk * MOBA_BLOCK

    def one_chunk(args):
        qc, ci = args
        q_start = ci * MOBA_Q_BLOCK
        own = q_start // MOBA_BLOCK
        gate = jnp.einsum('bhqd,bhnd->bhqn', qc.astype(jnp.float32), k_mean)
        gate = jnp.where(blk_ids < own, gate, -jnp.inf)
        _, sel = lax.top_k(gate, topk)
        sel_valid = sel < own
        k_sel = k_blocks[bi, hi, sel]
        v_sel = v_blocks[bi, hi, sel]
        s_sel = jnp.einsum('bhqd,bhqkjd->bhqkj', qc, k_sel).astype(jnp.float32) * scale
        s_sel = jnp.where(sel_valid[..., None], s_sel, -jnp.inf).reshape(b, h, MOBA_Q_BLOCK, n_sel)
        k_own = lax.dynamic_index_in_dim(k_blocks, own, axis=2, keepdims=False)
        v_own = lax.dynamic_index_in_dim(v_blocks, own, axis=2, keepdims=False)
        s_own = jnp.einsum('bhqd,bhjd->bhqj', qc, k_own).astype(jnp.float32) * scale
        causal = (own * MOBA_BLOCK + k_off)[None, :] <= (q_start + q_off)[:, None]
        s_own = jnp.where(causal, s_own, -jnp.inf)
        p = jax.nn.softmax(jnp.concatenate([s_sel, s_own], -1), axis=-1).astype(qc.dtype)
        p_sel = p[..., :n_sel].reshape(b, h, MOBA_Q_BLOCK, topk, MOBA_BLOCK)
        return (jnp.einsum('bhqkj,bhqkjd->bhqd', p_sel, v_sel)
                + jnp.einsum('bhqj,bhjd->bhqd', p[..., n_sel:], v_own))

    out = lax.map(one_chunk, (q_chunks, jnp.arange(nq)))
    return jnp.moveaxis(out, 0, 2).reshape(b, h, s, d)


def retention_moba_mixer(x, cos, sin, w_in, gn_gain, w_out):
    proj = x @ w_in
    qa, ka, va, ga, qb, kb, vb = jnp.split(proj, IN_SPLITS, axis=-1)
    ya = retention(apply_rope(split_heads(qa, N_RET_HEADS), cos, sin),
                   apply_rope(split_heads(ka, N_RET_HEADS), cos, sin),
                   split_heads(va, N_RET_HEADS))
    yf = ya.astype(jnp.float32)
    mu = jnp.mean(yf, -1, keepdims=True)
    var = jnp.mean(jnp.square(yf - mu), -1, keepdims=True)
    ya = merge_heads(((yf - mu) * lax.rsqrt(var + LN_EPS)).astype(x.dtype)) * gn_gain
    ya = ya * jax.nn.silu(ga)
    yb = merge_heads(moba_attention(apply_rope(split_heads(qb, N_MOBA_HEADS), cos, sin),
                                    apply_rope(split_heads(kb, N_MOBA_HEADS), cos, sin),
                                    split_heads(vb, N_MOBA_HEADS)))
    return jnp.concatenate([ya, yb], axis=-1) @ w_out


def gmlp_mixer(x, w_uv, b_uv, ln_g, ln_b, w_s, b_s, w_out):
    b, s, _ = x.shape
    hdn = jax.nn.gelu(x @ w_uv + b_uv)
    u, v = jnp.split(hdn, 2, axis=-1)
    v = layer_norm(v, ln_g, ln_b)
    n = s // GMLP_CHUNK
    v = v.reshape(b, n, GMLP_CHUNK, GMLP_GROUPS, GMLP_WIDTH // GMLP_GROUPS)
    causal = jnp.tril(jnp.ones((GMLP_CHUNK, GMLP_CHUNK), dtype=bool))
    ws = jnp.where(causal, w_s, jnp.zeros_like(w_s))
    v = jnp.einsum('gij,bnjgc->bnigc', ws, v) + b_s.T[:, :, None]
    return (u * v.reshape(b, s, GMLP_WIDTH)) @ w_out


def channel_mixer(x, w1, w2):
    return jnp.square(jax.nn.relu(x @ w1)) @ w2


def setup_inputs(seed: int = 0) -> dict:
    key = jax.random.key(seed)
    ks = jax.random.split(key, 18)
    f32 = jnp.float32
    nrm = lambda k, shape, scale: jax.random.normal(k, shape, f32) * scale
    x = jax.random.normal(ks[0], (BATCH, SEQ, D_MODEL), f32)
    offset = jax.random.randint(ks[1], (BATCH, 1), 0, 4096, dtype=jnp.int32)
    positions = offset + jnp.arange(SEQ, dtype=jnp.int32)[None, :]
    return {
        "x": x,
        "positions": positions,
        "ln_gain": 1.0 + nrm(ks[2], (DEPTH, 2, D_MODEL), 0.02),
        "ln_bias": nrm(ks[3], (DEPTH, 2, D_MODEL), 0.02),
        "mix_w_in": nrm(ks[4], (N_EVEN, D_MODEL, IN_COLS), D_MODEL ** -0.5),
        "ret_gn_gain": 1.0 + nrm(ks[5], (N_EVEN, RET_WIDTH), 0.02),
        "mix_w_out": nrm(ks[6], (N_EVEN, RET_WIDTH + MOBA_WIDTH, D_MODEL), (RET_WIDTH + MOBA_WIDTH) ** -0.5 * DEEPNORM_BETA),
        "gmlp_w_uv": nrm(ks[7], (N_ODD, D_MODEL, 2 * GMLP_WIDTH), D_MODEL ** -0.5),
        "gmlp_b_uv": nrm(ks[8], (N_ODD, 2 * GMLP_WIDTH), 0.02),
        "gmlp_ln_gain": 1.0 + nrm(ks[9], (N_ODD, GMLP_WIDTH), 0.02),
        "gmlp_ln_bias": nrm(ks[10], (N_ODD, GMLP_WIDTH), 0.02),
        "gmlp_w_s": nrm(ks[11], (N_ODD, GMLP_GROUPS, GMLP_CHUNK, GMLP_CHUNK), GMLP_CHUNK ** -0.5),
        "gmlp_b_s": 1.0 + nrm(ks[12], (N_ODD, GMLP_GROUPS, GMLP_CHUNK), 0.02),
        "gmlp_w_out": nrm(ks[13], (N_ODD, GMLP_WIDTH, D_MODEL), GMLP_WIDTH ** -0.5 * DEEPNORM_BETA),
        "ffn_w_in": nrm(ks[14], (DEPTH, D_MODEL, FFN_HIDDEN), D_MODEL ** -0.5),
        "ffn_w_out": nrm(ks[15], (DEPTH, FFN_HIDDEN, D_MODEL), FFN_HIDDEN ** -0.5 * DEEPNORM_BETA),
    }


def reference(x, positions, ln_gain, ln_bias, mix_w_in, ret_gn_gain, mix_w_out,
              gmlp_w_uv, gmlp_b_uv, gmlp_ln_gain, gmlp_ln_bias, gmlp_w_s, gmlp_b_s,
              gmlp_w_out, ffn_w_in, ffn_w_out):
    cos, sin = rope_tables(positions)
    for layer in range(DEPTH):
        i = layer // 2
        if layer % 2 == 0:
            y = retention_moba_mixer(x, cos, sin, mix_w_in[i], ret_gn_gain[i], mix_w_out[i])
        else:
            y = gmlp_mixer(x, gmlp_w_uv[i], gmlp_b_uv[i], gmlp_ln_gain[i], gmlp_ln_bias[i],
                           gmlp_w_s[i], gmlp_b_s[i], gmlp_w_out[i])
        x = layer_norm(DEEPNORM_ALPHA * x + y, ln_gain[layer, 0], ln_bias[layer, 0])
        y = channel_mixer(x, ffn_w_in[layer], ffn_w_out[layer])
        x = layer_norm(DEEPNORM_ALPHA * x + y, ln_gain[layer, 1], ln_bias[layer, 1])
    return x
```

```cpp
#include <hip/hip_runtime.h>
#include <hip/hip_cooperative_groups.h>
#include <cstdio>
#include <cstdint>
#include <cmath>
namespace cg = cooperative_groups;
#ifndef MK_MULTI
#define MK_MULTI 0
#endif
namespace pg8 {
#define PG8_LAS __attribute__((address_space(3)))
typedef unsigned short bf16_t;
typedef short bf16x8 __attribute__((ext_vector_type(8)));
typedef float f32x4 __attribute__((ext_vector_type(4)));
typedef unsigned u32x4 __attribute__((ext_vector_type(4)));
constexpr int BM = 256, BK = 64, HALF = 128, HTB = HALF * BK * 2  , STAGE_BYTES = 8 * HTB, NXCD = 8, WGM = 8;

__host__ __device__ __forceinline__ int lds_byte(int r, int c) { const int st = (r >> 4) * 2 + (c >> 5), rr = r & 15, cc = c & 31, ob = rr * 64 + cc * 2; return st * 1024 + (ob ^ (((ob >> 9) & 1) << 5)); }
__host__ __device__ __forceinline__ void stage_rc(int b, int& R, int& C) { const int st = b / 1024, sb = b % 1024, swz = sb ^ (((sb >> 9) & 1) << 5); R = (st >> 1) * 16 + swz / 64; C = (st & 1) * 32 + (swz % 64) / 2; }
__host__ __device__ __forceinline__ int perm32(int rho) { const int n = rho >> 4, i = rho & 15; return 8 * (i >> 2) + 4 * n + (i & 3); }

struct Unit { int pm, pn; };
struct Gemm { const bf16_t* A; const bf16_t* Bt; int M, N, K; };

struct StaticOrder {
    int nM, nN, nwg, G, c;
    __host__ __device__ void init(int M, int N, int G_, int c_) { nM = M / BM; nN = N / BM; nwg = nM * nN; G = G_; c = c_; }
    __host__ __device__ bool next(int i, Unit& u) const {
        const long L = (long)i * G + c; if (L >= nwg) return false;
        int wgid = (int)L; { const int q = nwg / NXCD, r = nwg % NXCD, xcd = wgid % NXCD, off = wgid / NXCD; wgid = (xcd < r ? xcd * (q + 1) : r * (q + 1) + (xcd - r) * q) + off; }
        const int nig = WGM * nN, gid = wgid / nig, fm = gid * WGM, gsz = (nM - fm) < WGM ? (nM - fm) : WGM;
        u.pm = fm + ((wgid % nig) % gsz); u.pn = (wgid % nig) / gsz; return true;
    }
    __device__ __forceinline__ void a_ready(const Unit&) const {}
    __device__ __forceinline__ void done(const Unit&) const {}
};

__device__ __forceinline__ unsigned cvt_pk_bf16(float lo, float hi) { unsigned r; asm volatile("v_cvt_pk_bf16_f32 %0, %1, %2" : "=v"(r) : "v"(lo), "v"(hi)); return r; }
typedef float f32x2 __attribute__((ext_vector_type(2)));
template <class Epi, class Sched, bool ALIGN_EPI = false, bool SP2 = false>
__device__ __forceinline__ void gemm_phase(PG8_LAS unsigned char* lds, const Gemm g, const Sched& S, const Epi& E) {
    int tid_o = threadIdx.x; asm volatile("" : "+v"(tid_o));
    const int tid = tid_o, wid = __builtin_amdgcn_readfirstlane(tid >> 6), lane = tid & 63, wr = wid >> 2, wc = wid & 3, fr = lane & 15, fq = lane >> 4;
    const int K = g.K, nt = K / BK;
    unsigned voffA[2], voffB[2];
#pragma unroll
    for (int i = 0; i < 2; ++i) { int R, C; stage_rc(tid * 16 + i * 8192, R, C); const int Rb = Epi::PERM ? ((R & ~31) + perm32(R & 31)) : R;
        voffA[i] = (unsigned)(R * K + C) * 2u; voffB[i] = (unsigned)(Rb * K + C) * 2u; }
    const size_t kstep = (size_t)(BK * 2);
    const size_t hstep = (size_t)HALF * K * 2;
    const size_t tstep = 2 * hstep;
    const unsigned ldsw = (unsigned)wid * 1024u;
    const int aoff = lds_byte(wr * 64 + fr, fq * 8), boff = lds_byte(wc * 32 + fr, fq * 8);
#define PG8_SA(b, h) (((b) * 2 + (h)) * HTB)
#define PG8_SB(b, h) ((4 + (b) * 2 + (h)) * HTB)
#define PG8_STAGE(bufoff, gbase, voff) do { _Pragma("unroll") for (int _i = 0; _i < 2; ++_i) \
        __builtin_amdgcn_global_load_lds((const unsigned*)((const char*)(gbase) + (voff)[_i]), (PG8_LAS unsigned*)(lds + (bufoff) + ldsw + _i * 8192), 16, 0, 0); } while (0)
#define PG8_LDA(dst, b, h) do { _Pragma("unroll") for (int m = 0; m < 4; ++m) _Pragma("unroll") for (int k = 0; k < 2; ++k) dst[m][k] = *(const PG8_LAS bf16x8*)(lds + PG8_SA(b, h) + aoff + m * 2048 + k * 1024); } while (0)
#define PG8_LDB(dst, b, h) do { _Pragma("unroll") for (int n = 0; n < 2; ++n) _Pragma("unroll") for (int k = 0; k < 2; ++k) dst[n][k] = *(const PG8_LAS bf16x8*)(lds + PG8_SB(b, h) + boff + n * 2048 + k * 1024); } while (0)
#define PG8_MMA(ai, bj, At, Bt) do { __builtin_amdgcn_s_setprio(1); _Pragma("unroll") for (int m = 0; m < 4; ++m) _Pragma("unroll") for (int n = 0; n < 2; ++n) _Pragma("unroll") for (int k = 0; k < 2; ++k) \
        acc[ai][bj][m][n] = __builtin_amdgcn_mfma_f32_16x16x32_bf16(Bt[n][k], At[m][k], acc[ai][bj][m][n], 0, 0, 0); __builtin_amdgcn_s_setprio(0); } while (0)
#define PG8_WAIT_V(n) asm volatile("s_waitcnt vmcnt(" #n ")" ::: "memory")
#define PG8_WAIT_L(n) asm volatile("s_waitcnt lgkmcnt(" #n ")" ::: "memory")
#define PG8_BAR __builtin_amdgcn_s_barrier()
#define PG8_SCHED __builtin_amdgcn_sched_barrier(0)
    Unit cur, nxt; int ui = 0;
    if (!S.next(0, cur)) return;
    f32x4 acc[2][2][4][2];
#pragma unroll
    for (int a = 0; a < 2; ++a)
#pragma unroll
        for (int b = 0; b < 2; ++b)
#pragma unroll
            for (int m = 0; m < 4; ++m)
#pragma unroll
                for (int n = 0; n < 2; ++n) acc[a][b][m][n] = (f32x4){0.f, 0.f, 0.f, 0.f};
    bf16x8 At[4][2], B0[2][2], B1[2][2];
    const char* cA = (const char*)g.A + (size_t)cur.pm * tstep; const char* cB = (const char*)g.Bt + (size_t)cur.pn * tstep;
    S.a_ready(cur);
    if constexpr (SP2) {
        PG8_STAGE(PG8_SB(0, 0), cB, voffB); PG8_STAGE(PG8_SB(0, 1), cB + hstep, voffB); PG8_STAGE(PG8_SA(0, 0), cA, voffA); PG8_STAGE(PG8_SA(0, 1), cA + hstep, voffA);
        if (wr == 1) PG8_BAR;
        PG8_WAIT_V(2); PG8_BAR;
        PG8_STAGE(PG8_SB(1, 0), cB + kstep, voffB); PG8_STAGE(PG8_SA(1, 0), cA + kstep, voffA); PG8_STAGE(PG8_SB(1, 1), cB + hstep + kstep, voffB);
        PG8_WAIT_V(6); PG8_BAR;
    } else {
        PG8_STAGE(PG8_SB(0, 0), cB, voffB); PG8_STAGE(PG8_SA(0, 0), cA, voffA); PG8_STAGE(PG8_SB(0, 1), cB + hstep, voffB); PG8_STAGE(PG8_SA(0, 1), cA + hstep, voffA);
        if (wr == 1) PG8_BAR;
        PG8_WAIT_V(4); PG8_BAR;
        PG8_STAGE(PG8_SB(1, 0), cB + kstep, voffB); PG8_STAGE(PG8_SA(1, 0), cA + kstep, voffA); PG8_STAGE(PG8_SB(1, 1), cB + hstep + kstep, voffB);
        PG8_WAIT_V(6); PG8_BAR;
    }
    for (;;) {
        const bool has_next = S.next(ui + 1, nxt);
        const char* nA = has_next ? (const char*)g.A + (size_t)nxt.pm * tstep : cA; const char* nB = has_next ? (const char*)g.Bt + (size_t)nxt.pn * tstep : cB;
        for (int t = 0; t < nt; t += 2) {
            const bool last = (t == nt - 2);
            const char* a1 = cA + (size_t)(t + 1) * kstep;
            const char* a2 = last ? nA : cA + (size_t)(t + 2) * kstep; const char* b2 = last ? nB : cB + (size_t)(t + 2) * kstep;
            const char* a3 = a2 + kstep; const char* b3 = b2 + kstep;
            if (last && has_next) S.a_ready(nxt);
            if constexpr (SP2) {
            PG8_LDB(B0, 0, 0); PG8_LDB(B1, 0, 1); PG8_SCHED; PG8_LDA(At, 0, 0); PG8_STAGE(PG8_SA(1, 1), a1 + hstep, voffA);
            PG8_WAIT_V(8); PG8_WAIT_L(0); PG8_BAR; PG8_MMA(0, 0, At, B0); PG8_MMA(0, 1, At, B1); PG8_BAR; PG8_SCHED;
            PG8_LDA(At, 0, 1); PG8_STAGE(PG8_SB(0, 0), b2, voffB); PG8_STAGE(PG8_SB(0, 1), b2 + hstep, voffB); PG8_STAGE(PG8_SA(0, 0), a2, voffA);
            PG8_WAIT_V(8); PG8_WAIT_L(0); PG8_BAR; PG8_MMA(1, 0, At, B0); PG8_MMA(1, 1, At, B1); PG8_BAR; PG8_SCHED;
            PG8_LDB(B0, 1, 0); PG8_LDB(B1, 1, 1); PG8_SCHED; PG8_LDA(At, 1, 0); PG8_STAGE(PG8_SA(0, 1), a2 + hstep, voffA);
            PG8_WAIT_V(8); PG8_WAIT_L(0); PG8_BAR; PG8_MMA(0, 0, At, B0); PG8_MMA(0, 1, At, B1); PG8_BAR; PG8_SCHED;
            PG8_LDA(At, 1, 1); PG8_STAGE(PG8_SB(1, 0), b3, voffB); PG8_STAGE(PG8_SB(1, 1), b3 + hstep, voffB); PG8_STAGE(PG8_SA(1, 0), a3, voffA);
            PG8_WAIT_V(8); PG8_WAIT_L(0); PG8_BAR; PG8_MMA(1, 0, At, B0); PG8_MMA(1, 1, At, B1); PG8_BAR; PG8_SCHED;
            } else {
            PG8_LDB(B0, 0, 0); PG8_SCHED; PG8_LDA(At, 0, 0); PG8_STAGE(PG8_SA(1, 1), a1 + hstep, voffA);
            PG8_WAIT_L(8); PG8_BAR; PG8_WAIT_L(0); PG8_MMA(0, 0, At, B0); PG8_BAR; PG8_SCHED;
            PG8_LDB(B1, 0, 1); PG8_STAGE(PG8_SB(0, 0), b2, voffB);
            PG8_BAR; PG8_WAIT_L(0); PG8_MMA(0, 1, At, B1); PG8_BAR;
            PG8_LDA(At, 0, 1); PG8_STAGE(PG8_SA(0, 0), a2, voffA);
            PG8_BAR; PG8_WAIT_L(0); PG8_MMA(1, 0, At, B0); PG8_BAR; PG8_SCHED;
            PG8_STAGE(PG8_SB(0, 1), b2 + hstep, voffB);
            PG8_WAIT_V(6); PG8_BAR; PG8_MMA(1, 1, At, B1); PG8_BAR;
            PG8_LDB(B0, 1, 0); PG8_SCHED; PG8_LDA(At, 1, 0); PG8_STAGE(PG8_SA(0, 1), a2 + hstep, voffA);
            PG8_WAIT_L(8); PG8_BAR; PG8_WAIT_L(0); PG8_MMA(0, 0, At, B0); PG8_BAR; PG8_SCHED;
            PG8_LDB(B1, 1, 1); PG8_STAGE(PG8_SB(1, 0), b3, voffB);
            PG8_BAR; PG8_WAIT_L(0); PG8_MMA(0, 1, At, B1); PG8_BAR;
            PG8_LDA(At, 1, 1); PG8_STAGE(PG8_SA(1, 0), a3, voffA);
            PG8_BAR; PG8_WAIT_L(0); PG8_MMA(1, 0, At, B0); PG8_BAR; PG8_SCHED;
            PG8_STAGE(PG8_SB(1, 1), b3 + hstep, voffB);
            PG8_WAIT_V(6); PG8_BAR; PG8_MMA(1, 1, At, B1); PG8_BAR;
            }
        }
        if constexpr (ALIGN_EPI) { if (wr == 0) PG8_BAR; }
        if constexpr (!Epi::AFTER_DRAIN) { E(acc, cur, wr, wc, fr, fq); S.done(cur); }
        if (!has_next) break;
#pragma unroll
        for (int a = 0; a < 2; ++a)
#pragma unroll
            for (int b = 0; b < 2; ++b)
#pragma unroll
                for (int m = 0; m < 4; ++m)
#pragma unroll
                    for (int n = 0; n < 2; ++n) acc[a][b][m][n] = (f32x4){0.f, 0.f, 0.f, 0.f};
        cur = nxt; cA = nA; cB = nB; ++ui;
        if constexpr (ALIGN_EPI) { if (wr == 1) PG8_BAR; }
    }
    PG8_WAIT_V(0);
    if constexpr (!ALIGN_EPI) { if (wr == 0) PG8_BAR; }
    PG8_BAR;
    if constexpr (Epi::AFTER_DRAIN) { E.fused(acc, cur, wr, wc, fr, fq, lds, wid, lane); S.done(cur); }
#undef PG8_SA
#undef PG8_SB
#undef PG8_STAGE
#undef PG8_LDA
#undef PG8_LDB
#undef PG8_MMA
#undef PG8_WAIT_V
#undef PG8_WAIT_L
#undef PG8_BAR
#undef PG8_SCHED
}
}
using pg8::bf16_t; using pg8::bf16x8; using pg8::f32x4; using pg8::u32x4; using pg8::Unit;
#define DI __device__ __forceinline__
#define LAS __attribute__((address_space(3)))
typedef float f32x2_t __attribute__((ext_vector_type(2)));
typedef __bf16 bf16x2_t __attribute__((ext_vector_type(2)));
typedef unsigned u32x2 __attribute__((ext_vector_type(2)));

constexpr int T = 32768, SEQ = 8192, DM = 1024;
constexpr int P1C = 2560;
constexpr int OFF_QA = 0, OFF_KA = 512, OFF_QB = 1024, OFF_KB = 1536, OFF_GA = 2048;
constexpr float ALPHA = 1.6817928305074292f, LN_EPS = 1e-5f;
constexpr size_t MiB = 1u << 20;
constexpr size_t WS_CTL = 0, WS_W = 1 * MiB, WS_CS = 29 * MiB, WS_SN = 33 * MiB, WS_XB = 37 * MiB, WS_BIG = 101 * MiB;
constexpr size_t WS_P1 = WS_BIG, WS_VT = WS_BIG + 160 * MiB, WS_PO = WS_BIG + 224 * MiB, WS_PML = WS_BIG + 352 * MiB, WS_KV = WS_BIG + 360 * MiB, WS_LST = WS_BIG + 392 * MiB, WS_KM = WS_BIG + 401 * MiB;
constexpr size_t WS_H = WS_BIG, WS_HU = WS_BIG, WS_VT2 = WS_BIG + 128 * MiB, WS_SG = WS_BIG + 256 * MiB, WS_VST = WS_BIG + 384 * MiB;
constexpr size_t WS_NEED = 512 * MiB;
constexpr size_t WE_A = 0, WE_O = (size_t)4 << 20, WE_1 = (size_t)6 << 20, WE_2 = (size_t)10 << 20;
constexpr int LDS_BYTES = 147456;
constexpr int LCAP = 126976;
constexpr int N_PHASES = 35;
#ifndef PM
#define PM 0x1ffff
#endif
#define EN(k) (((PM) >> (k)) & 1)

__device__ const float INVF[32] = {1.000000000e+00f, 7.498942614e-01f, 5.623413324e-01f, 4.216965139e-01f, 3.162277639e-01f, 2.371373773e-01f, 1.778279394e-01f, 1.333521307e-01f, 1.000000015e-01f, 7.498941571e-02f, 5.623413250e-02f, 4.216965288e-02f, 3.162277490e-02f, 2.371373773e-02f, 1.778279431e-02f, 1.333521493e-02f, 9.999999776e-03f, 7.498941850e-03f, 5.623413250e-03f, 4.216964822e-03f, 3.162277630e-03f, 2.371373586e-03f, 1.778279431e-03f, 1.333521446e-03f, 1.000000047e-03f, 7.498942432e-04f, 5.623413017e-04f, 4.216965172e-04f, 3.162277571e-04f, 2.371373703e-04f, 1.778279402e-04f, 1.333521504e-04f};
__device__ const float LGAM[8] = {-3.174869716e-02f, -1.574835740e-02f, -7.843177766e-03f, -3.913899418e-03f, -1.955034910e-03f, -9.770396864e-04f, -4.884005175e-04f, -2.441704273e-04f};

DI unsigned pk2(float lo, float hi) { f32x2_t v = {lo, hi}; bf16x2_t b = __builtin_convertvector(v, bf16x2_t); return __builtin_bit_cast(unsigned, b); }
DI float bflo(unsigned w) { return __uint_as_float(w << 16); }
DI float bfhi(unsigned w) { return __uint_as_float(w & 0xffff0000u); }
DI float bf2f(bf16_t h) { return __uint_as_float((unsigned)h << 16); }
DI bf16x8 pack8(float a0, float a1, float a2, float a3, float a4, float a5, float a6, float a7) { u32x4 w = {pk2(a0, a1), pk2(a2, a3), pk2(a4, a5), pk2(a6, a7)}; return __builtin_bit_cast(bf16x8, w); }
DI bf16x8 pack44(f32x4 a, f32x4 b) { return pack8(a[0], a[1], a[2], a[3], b[0], b[1], b[2], b[3]); }
DI f32x4 mfma16(bf16x8 a, bf16x8 b, f32x4 c) { return __builtin_amdgcn_mfma_f32_16x16x32_bf16(a, b, c, 0, 0, 0); }
DI float wave_sum(float v) {
#pragma unroll
    for (int o = 1; o < 64; o <<= 1) v += __shfl_xor(v, o);
    return v;
}
DI float gelu_tanh(float x) { const float u = 0.7978845608028654f * (x + 0.044715f * x * x * x); return x * __builtin_amdgcn_rcpf(1.f + __expf(-2.f * u)); }
DI float relu2(float x) { const float r = fmaxf(x, 0.f); return r * r; }
DI float silu(float x) { return x * __builtin_amdgcn_rcpf(1.f + __expf(-x)); }
#define LDS_WAIT() asm volatile("s_waitcnt lgkmcnt(0)" ::: "memory")

template <int ACT  > struct EpiAct {
    static constexpr bool PERM = true, AFTER_DRAIN = false;
    bf16_t* O; int ldc; const float* bias;
    DI void operator()(const f32x4 (&acc)[2][2][4][2], const Unit& u, int wr, int wc, int fr, int fq) const {
        const int row0 = u.pm * 256 + wr * 64 + fr, col0 = u.pn * 256 + wc * 32 + 8 * fq;
        f32x4 bv[2][2];
#pragma unroll
        for (int bj = 0; bj < 2; ++bj)
#pragma unroll
            for (int n = 0; n < 2; ++n) bv[bj][n] = (ACT == 2) ? *(const f32x4*)(bias + col0 + bj * 128 + 4 * n) : (f32x4){0.f, 0.f, 0.f, 0.f};
#pragma unroll
        for (int ai = 0; ai < 2; ++ai)
#pragma unroll
            for (int m = 0; m < 4; ++m) { bf16_t* rowp = O + (size_t)(row0 + ai * 128 + m * 16) * ldc + col0;
#pragma unroll
                for (int bj = 0; bj < 2; ++bj) { f32x4 v0 = acc[ai][bj][m][0] + bv[bj][0], v1 = acc[ai][bj][m][1] + bv[bj][1];
#pragma unroll
                    for (int j = 0; j < 4; ++j) { if (ACT == 1) { v0[j] = relu2(v0[j]); v1[j] = relu2(v1[j]); } if (ACT == 2) { v0[j] = gelu_tanh(v0[j]); v1[j] = gelu_tanh(v1[j]); } }
                    u32x4 w; w.x = pk2(v0[0], v0[1]); w.y = pk2(v0[2], v0[3]); w.z = pk2(v1[0], v1[1]); w.w = pk2(v1[2], v1[3]);
                    *(u32x4*)(rowp + bj * 128) = w; } }
    }
};
struct EpiRope {
    static constexpr bool PERM = true, AFTER_DRAIN = false;
    bf16_t* O; int ldc; const float* cs; const float* sn; int rope_tiles;
    DI void operator()(const f32x4 (&acc)[2][2][4][2], const Unit& u, int wr, int wc, int fr, int fq) const {
        const int row0 = u.pm * 256 + wr * 64 + fr, col0 = u.pn * 256 + wc * 32 + 8 * fq;
        const bool rope = u.pn < rope_tiles; const int i0 = 16 * (wc & 1) + 4 * fq;
#pragma unroll
        for (int ai = 0; ai < 2; ++ai)
#pragma unroll
            for (int m = 0; m < 4; ++m) { const int row = row0 + ai * 128 + m * 16; bf16_t* rowp = O + (size_t)row * ldc + col0;
                f32x4 c4 = {1.f, 1.f, 1.f, 1.f}, s4 = {0.f, 0.f, 0.f, 0.f};
                if (rope) { c4 = *(const f32x4*)(cs + (size_t)row * 32 + i0); s4 = *(const f32x4*)(sn + (size_t)row * 32 + i0); }
#pragma unroll
                for (int bj = 0; bj < 2; ++bj) { const f32x4 v0 = acc[ai][bj][m][0], v1 = acc[ai][bj][m][1];
                    const float a0 = v0[0] * c4[0] - v0[1] * s4[0], b0 = v0[1] * c4[0] + v0[0] * s4[0];
                    const float a1 = v0[2] * c4[1] - v0[3] * s4[1], b1 = v0[3] * c4[1] + v0[2] * s4[1];
                    const float a2 = v1[0] * c4[2] - v1[1] * s4[2], b2 = v1[1] * c4[2] + v1[0] * s4[2];
                    const float a3 = v1[2] * c4[3] - v1[3] * s4[3], b3 = v1[3] * c4[3] + v1[2] * s4[3];
                    u32x4 w; w.x = pk2(a0, b0); w.y = pk2(a1, b1); w.z = pk2(a2, b2); w.w = pk2(a3, b3);
                    *(u32x4*)(rowp + bj * 128) = w; }
                asm volatile("" ::: "memory"); }
    }
};
struct EpiRes {
    static constexpr bool PERM = true, AFTER_DRAIN = false;
    float* X;
    DI void operator()(const f32x4 (&acc)[2][2][4][2], const Unit& u, int wr, int wc, int fr, int fq) const {
        const int row0 = u.pm * 256 + wr * 64 + fr, col0 = u.pn * 256 + wc * 32 + 8 * fq;
#pragma unroll
        for (int ai = 0; ai < 2; ++ai)
#pragma unroll
            for (int m = 0; m < 4; ++m) { float* rowp = X + (size_t)(row0 + ai * 128 + m * 16) * DM + col0;
#pragma unroll
                for (int bj = 0; bj < 2; ++bj) { f32x4 x0 = *(const f32x4*)(rowp + bj * 128), x1 = *(const f32x4*)(rowp + bj * 128 + 4);
                    x0 = x0 * ALPHA + acc[ai][bj][m][0]; x1 = x1 * ALPHA + acc[ai][bj][m][1];
                    *(f32x4*)(rowp + bj * 128) = x0; *(f32x4*)(rowp + bj * 128 + 4) = x1; } }
    }
};
struct EpiVt {
    static constexpr bool PERM = true, AFTER_DRAIN = false;
    bf16_t* O; const float* bias; float* vst;
    DI void operator()(const f32x4 (&acc)[2][2][4][2], const Unit& u, int wr, int wc, int fr, int fq) const {
        const int row0 = u.pm * 256 + wr * 64 + fr, col0 = u.pn * 256 + wc * 32 + 8 * fq;
#pragma unroll
        for (int bj = 0; bj < 2; ++bj) {
            f32x4 s1[2] = {{0.f, 0.f, 0.f, 0.f}, {0.f, 0.f, 0.f, 0.f}}, s2[2] = {{0.f, 0.f, 0.f, 0.f}, {0.f, 0.f, 0.f, 0.f}};
#pragma unroll
            for (int ai = 0; ai < 2; ++ai)
#pragma unroll
                for (int m = 0; m < 4; ++m) { const int row = row0 + ai * 128 + m * 16; const float b = bias[row];
                    f32x4 v0 = acc[ai][bj][m][0] + b, v1 = acc[ai][bj][m][1] + b;
#pragma unroll
                    for (int j = 0; j < 4; ++j) { v0[j] = gelu_tanh(v0[j]); v1[j] = gelu_tanh(v1[j]); }
                    s1[0] += v0; s1[1] += v1; s2[0] += v0 * v0; s2[1] += v1 * v1;
                    u32x4 w; w.x = pk2(v0[0], v0[1]); w.y = pk2(v0[2], v0[3]); w.z = pk2(v1[0], v1[1]); w.w = pk2(v1[2], v1[3]);
                    *(u32x4*)(O + (size_t)row * T + col0 + bj * 128) = w; }
#pragma unroll
            for (int n = 0; n < 2; ++n)
#pragma unroll
                for (int j = 0; j < 4; ++j) { float a = s1[n][j], q = s2[n][j];
#pragma unroll
                    for (int o = 1; o < 16; o <<= 1) { a += __shfl_xor(a, o); q += __shfl_xor(q, o); }
                    if (fr == 0) { const int tok = col0 + bj * 128 + 4 * n + j; *(f32x2_t*)(vst + ((size_t)tok * 16 + u.pm * 2 + wr) * 2) = (f32x2_t){a, q}; } }
        }
    }
};

DI void sincos_acc(float ang, float& s, float& c) {
    const double a = (double)ang;
    const double kq = __builtin_rint(a * 0.63661977236758134308);
    double r = __builtin_fma(-kq, 1.57079632673412561417e+00, a);
    r = __builtin_fma(-kq, 6.07710050650619224932e-11, r);
    const int q = (int)kq & 3;
    const double r2 = r * r;
    const double sp = r + r * r2 * (-1.66666666666666324348e-01 + r2 * (8.33333333332248946124e-03 + r2 * (-1.98412698298579493134e-04 + r2 * (2.75573137070700676789e-06 + r2 * (-2.50507602534068634195e-08 + r2 * 1.58969099521155010221e-10)))));
    const double cp = 1.0 - 0.5 * r2 + r2 * r2 * (4.16666666666666019037e-02 + r2 * (-1.38888888888741095749e-03 + r2 * (2.48015872894767294178e-05 + r2 * (-2.75573143513906633035e-07 + r2 * (2.08757232129817482790e-09 + r2 * -1.13596475577881948265e-11)))));
    const double ss = (q & 1) ? cp : sp, cc = (q & 1) ? sp : cp;
    s = (float)((q & 2) ? -ss : ss);
    c = (float)((q == 1 || q == 2) ? -cc : cc);
}
DI void phase0(const float* x, const int* pos, float* xf, bf16_t* xb, float* cs, float* sn, int gtid, int nth) {
    for (int idx = gtid; idx < T * 32; idx += nth) { const int tok = idx >> 5, i = idx & 31; const float ang = (float)pos[tok] * INVF[i]; float s, c; sincos_acc(ang, s, c); cs[idx] = c; sn[idx] = s; }
    for (int idx = gtid; idx < T * DM / 4; idx += nth) { const f32x4 v = ((const f32x4*)x)[idx]; ((f32x4*)xf)[idx] = v; u32x2 w; w.x = pk2(v[0], v[1]); w.y = pk2(v[2], v[3]); ((u32x2*)xb)[idx] = w; }
}
DI int wmap(int n, int mode) {
    if (mode == 0) return n;
    const int seg = n >> 9, w = n & 511;
    const int base = seg == 0 ? 0 : seg == 1 ? 512 : seg == 2 ? 2560 : seg == 3 ? 2048 : seg == 4 ? 1024 : seg == 5 ? 1536 : 3072;
    const bool rope = (seg == 0) || (seg == 1) || (seg == 4) || (seg == 5);
    if (!rope) return base + w;
    const int hb = w & ~63, d = w & 63;
    return base + hb + 2 * (d & 31) + (d >> 5);
}
DI void wt_item(const float* W, int K, int N, bf16_t* WT, int mode, LAS float* scr, int item, int lane) {
    const int nblk = N / 32, kb = item / nblk, nb = item % nblk, k0 = 64 * kb, n0 = 32 * nb;
#pragma unroll 8
    for (int i = 0; i < 32; ++i) { const int kk = 2 * i + (lane >> 5); scr[kk * 33 + (lane & 31)] = W[(size_t)(k0 + kk) * N + n0 + (lane & 31)]; }
    LDS_WAIT();
    const int c = lane & 7;
#pragma unroll
    for (int j = 0; j < 4; ++j) { const int n = (lane >> 3) + 8 * j; const LAS float* s = scr + (8 * c) * 33 + n;
        u32x4 o; o.x = pk2(s[0 * 33], s[1 * 33]); o.y = pk2(s[2 * 33], s[3 * 33]); o.z = pk2(s[4 * 33], s[5 * 33]); o.w = pk2(s[6 * 33], s[7 * 33]);
        *(u32x4*)(WT + (size_t)wmap(n0 + n, mode) * K + k0 + 8 * c) = o; }
    LDS_WAIT();
}
DI void conv_weights(const float* const* in, int layer, bf16_t* Wb, LAS unsigned char* lds, int gw, int ngw, int wave, int lane) {
    LAS float* scr = (LAS float*)(lds + wave * 16384);
    const int li = layer >> 1;
    const float* w1 = in[14] + (size_t)layer * 1024 * 4096; const float* w2 = in[15] + (size_t)layer * 4096 * 1024;
    if (!(layer & 1)) {
        const float* win = in[4] + (size_t)li * 1024 * 3584; const float* wo = in[6] + (size_t)li * 1024 * 1024;
        constexpr int I_A = 16 * 112, I_O = 16 * 32, I_1 = 16 * 128, I_2 = 64 * 32;
        for (int it = gw; it < I_A + I_O + I_1 + I_2; it += ngw) { int r = it;
            if (r < I_A) { wt_item(win, 1024, 3584, Wb + WE_A, 1, scr, r, lane); continue; } r -= I_A;
            if (r < I_O) { wt_item(wo, 1024, 1024, Wb + WE_O, 0, scr, r, lane); continue; } r -= I_O;
            if (r < I_1) { wt_item(w1, 1024, 4096, Wb + WE_1, 0, scr, r, lane); continue; } r -= I_1;
            wt_item(w2, 4096, 1024, Wb + WE_2, 0, scr, r, lane); }
    } else {
        const float* wuv = in[7] + (size_t)li * 1024 * 4096; const float* wo = in[13] + (size_t)li * 2048 * 1024;
        constexpr int I_A = 16 * 128, I_O = 32 * 32, I_1 = 16 * 128, I_2 = 64 * 32;
        for (int it = gw; it < I_A + I_O + I_1 + I_2; it += ngw) { int r = it;
            if (r < I_A) { wt_item(wuv, 1024, 4096, Wb + WE_A, 0, scr, r, lane); continue; } r -= I_A;
            if (r < I_O) { wt_item(wo, 2048, 1024, Wb + WE_O, 0, scr, r, lane); continue; } r -= I_O;
            if (r < I_1) { wt_item(w1, 1024, 4096, Wb + WE_1, 0, scr, r, lane); continue; } r -= I_1;
            wt_item(w2, 4096, 1024, Wb + WE_2, 0, scr, r, lane); }
    }
}
DI void ln_phase(float* xf, bf16_t* xb, const float* g, const float* b, int gw, int ngw, int lane) {
    for (int m = gw; m < T; m += ngw) {
        f32x4* xr = (f32x4*)(xf + (size_t)m * DM) + lane;
        f32x4 v[4]; float s = 0.f;
#pragma unroll
        for (int j = 0; j < 4; ++j) { v[j] = xr[64 * j]; s += (v[j][0] + v[j][1]) + (v[j][2] + v[j][3]); }
        const float mean = wave_sum(s) * (1.f / DM); float s2 = 0.f;
#pragma unroll
        for (int j = 0; j < 4; ++j) { v[j] = v[j] - mean; s2 += (v[j][0] * v[j][0] + v[j][1] * v[j][1]) + (v[j][2] * v[j][2] + v[j][3] * v[j][3]); }
        const float rstd = 1.f / sqrtf(wave_sum(s2) * (1.f / DM) + LN_EPS);
        u32x2* o8 = (u32x2*)(xb + (size_t)m * DM) + lane;
#pragma unroll
        for (int j = 0; j < 4; ++j) { const f32x4 gg = ((const f32x4*)g)[lane + 64 * j], bb = ((const f32x4*)b)[lane + 64 * j]; const f32x4 o = v[j] * rstd * gg + bb;
            xr[64 * j] = o; u32x2 w; w.x = pk2(o[0], o[1]); w.y = pk2(o[2], o[3]); o8[64 * j] = w; }
    }
}

DI void kmean_phase(const bf16_t* P1, float* KM, int gw, int ngw, int lane) {
    for (int u = gw; u < 1024; u += ngw) {
        const int bh = u >> 5, j = u & 31, b = bh >> 3, h = bh & 7, c8 = lane & 7, rg = lane >> 3;
        const bf16_t* p = P1 + (size_t)(b * SEQ + j * 256 + rg) * P1C + OFF_KB + h * 64 + c8 * 8;
        float a[8];
#pragma unroll
        for (int e = 0; e < 8; ++e) a[e] = 0.f;
        for (int it = 0; it < 32; ++it) { const u32x4 w = *(const u32x4*)(p + (size_t)it * 8 * P1C);
            a[0] += bflo(w.x); a[1] += bfhi(w.x); a[2] += bflo(w.y); a[3] += bfhi(w.y); a[4] += bflo(w.z); a[5] += bfhi(w.z); a[6] += bflo(w.w); a[7] += bfhi(w.w); }
#pragma unroll
        for (int e = 0; e < 8; ++e) { a[e] += __shfl_xor(a[e], 8); a[e] += __shfl_xor(a[e], 16); a[e] += __shfl_xor(a[e], 32); }
        if (rg == 0) { float* o = KM + (size_t)u * 64 + c8 * 8;
            *(f32x4*)o = (f32x4){a[0], a[1], a[2], a[3]} * (1.f / 256.f); *(f32x4*)(o + 4) = (f32x4){a[4], a[5], a[6], a[7]} * (1.f / 256.f); }
    }
}
DI int lst_off(int j) { return 8192 * j - 128 * j * (j + 1); }
DI void gate_phase(const bf16_t* P1, const float* KM, unsigned* cnt, unsigned short* lst, int gw, int ngw, int lane) {
    for (int u = gw; u < 4096; u += ngw) {
        const int bh = u >> 7, qc = u & 127, own = qc >> 2;
        if (own == 0) continue;
        const int b = bh >> 3, h = bh & 7, ql = qc * 64 + lane;
        const bf16_t* qp = P1 + (size_t)(b * SEQ + ql) * P1C + OFF_QB + h * 64;
        float qf[64];
#pragma unroll
        for (int c = 0; c < 8; ++c) { const u32x4 w = *(const u32x4*)(qp + 8 * c);
            qf[8 * c + 0] = bflo(w.x); qf[8 * c + 1] = bfhi(w.x); qf[8 * c + 2] = bflo(w.y); qf[8 * c + 3] = bfhi(w.y); qf[8 * c + 4] = bflo(w.z); qf[8 * c + 5] = bfhi(w.z); qf[8 * c + 6] = bflo(w.w); qf[8 * c + 7] = bfhi(w.w); }
        float v0 = -INFINITY, v1 = -INFINITY, v2 = -INFINITY; int i0 = 0, i1 = 0, i2 = 0;
        const float* km = KM + (size_t)bh * 32 * 64;
        for (int j = 0; j < own; ++j) { float g = 0.f;
#pragma unroll
            for (int d = 0; d < 64; ++d) g += qf[d] * km[j * 64 + d];
            if (g > v0) { v2 = v1; i2 = i1; v1 = v0; i1 = i0; v0 = g; i0 = j; } else if (g > v1) { v2 = v1; i2 = i1; v1 = g; i1 = j; } else if (g > v2) { v2 = g; i2 = j; } }
        const int nsel = own < 3 ? own : 3;
#pragma unroll
        for (int s = 0; s < 3; ++s) if (s < nsel) { const int j = s == 0 ? i0 : s == 1 ? i1 : i2;
            const unsigned p = atomicAdd(&cnt[bh * 32 + j], 1u);
            lst[(size_t)bh * LCAP + lst_off(j) + p] = (unsigned short)(ql | (s << 13)); }
    }
}
DI void moba_phase(const bf16_t* P1, const bf16_t* VT, const unsigned* cnt, const unsigned short* lst, bf16_t* PO, float* PML, LAS unsigned char* lds, int tid, int wave, int lane) {
    LAS int* pref = (LAS int*)(lds + 73728); LAS int* ntl = (LAS int*)(lds + 77824); LAS int* totw = (LAS int*)(lds + 81920);
    for (int p = tid; p < 1024; p += 512) { int v = 0; if (p < 992) { const int bh = p / 31, j = p % 31; v = (int)((cnt[bh * 32 + j] + 127u) >> 7); } ntl[p] = v; }
    __syncthreads();
    if (wave == 0) { const int base = lane * 16; int s = 0;
#pragma unroll
        for (int k = 0; k < 16; ++k) s += ntl[base + k];
        int incl = s;
#pragma unroll
        for (int o = 1; o < 64; o <<= 1) { const int t = __shfl_up(incl, o); if (lane >= o) incl += t; }
        int run = incl - s;
#pragma unroll
        for (int k = 0; k < 16; ++k) { pref[base + k] = run; run += ntl[base + k]; }
        if (lane == 63) totw[0] = incl; }
    __syncthreads();
    const int total_sel = totw[0], total = total_sel + 2048;
    const int r = lane & 15, q = lane >> 4;
    for (int it = blockIdx.x; it < total; it += gridDim.x) {
        int bh, blk, t, cntv; bool ownit;
        if (it < total_sel) { int lo = 0, hi = 991; while (lo < hi) { const int mid = (lo + hi + 1) >> 1; if (pref[mid] <= it) lo = mid; else hi = mid - 1; }
            bh = lo / 31; blk = lo % 31; t = it - pref[lo]; cntv = (int)cnt[bh * 32 + blk]; ownit = false; }
        else { const int o = it - total_sel; bh = o >> 6; t = o & 63; blk = t >> 1; cntv = 0; ownit = true; }
        const int b = bh >> 3, h = bh & 7; const size_t tokb = (size_t)b * SEQ + blk * 256;
#pragma unroll
        for (int i = 0; i < 4; ++i) { const int c = tid + 512 * i, row = c >> 3, cc = c & 7;
            *(LAS u32x4*)(lds + row * 144 + cc * 16) = *(const u32x4*)(P1 + (tokb + row) * P1C + OFF_KB + h * 64 + cc * 8); }
#pragma unroll
        for (int i = 0; i < 4; ++i) { const int c = tid + 512 * i, row = c >> 5, cc = c & 31;
            *(LAS u32x4*)(lds + 36864 + row * 528 + cc * 16) = *(const u32x4*)(VT + (size_t)(512 + h * 64 + row) * T + tokb + cc * 8); }
        __syncthreads();
        const int qi = wave * 16 + r; int ql, slot; bool valid;
        if (ownit) { ql = t * 128 + qi; slot = 3; valid = true; }
        else { const int li = t * 128 + qi; valid = li < cntv; const unsigned e = lst[(size_t)bh * LCAP + lst_off(blk) + (valid ? li : 0)]; ql = (int)(e & 8191u); slot = (int)(e >> 13); }
        const size_t tokq = (size_t)b * SEQ + ql;
        bf16x8 bq[2];
#pragma unroll
        for (int ks = 0; ks < 2; ++ks) bq[ks] = *(const bf16x8*)(P1 + tokq * P1C + OFF_QB + h * 64 + ks * 32 + q * 8);
        f32x4 st[16];
#pragma unroll
        for (int kt = 0; kt < 16; ++kt) { f32x4 a = {0.f, 0.f, 0.f, 0.f};
#pragma unroll
            for (int ks = 0; ks < 2; ++ks) { const bf16x8 ka = *(const LAS bf16x8*)(lds + (16 * kt + r) * 144 + ks * 64 + q * 16); a = mfma16(ka, bq[ks], a); }
            st[kt] = a; }
        const float SC = 0.125f * 1.4426950408889634f; const int pq = ql & 255;
        float m = -INFINITY;
#pragma unroll
        for (int kt = 0; kt < 16; ++kt)
#pragma unroll
            for (int s = 0; s < 4; ++s) { float v = st[kt][s] * SC; if (ownit && (16 * kt + 4 * q + s) > pq) v = -INFINITY; st[kt][s] = v; m = fmaxf(m, v); }
        m = fmaxf(m, __shfl_xor(m, 16)); m = fmaxf(m, __shfl_xor(m, 32));
        float l = 0.f;
#pragma unroll
        for (int kt = 0; kt < 16; ++kt)
#pragma unroll
            for (int s = 0; s < 4; ++s) { const float p = exp2f(st[kt][s] - m); st[kt][s] = p; l += p; }
        l += __shfl_xor(l, 16); l += __shfl_xor(l, 32);
        bf16x8 pf[8];
#pragma unroll
        for (int kk = 0; kk < 8; ++kk) pf[kk] = pack44(st[2 * kk], st[2 * kk + 1]);
        f32x4 o[4];
#pragma unroll
        for (int et = 0; et < 4; ++et) { f32x4 a = {0.f, 0.f, 0.f, 0.f};
#pragma unroll
            for (int kk = 0; kk < 8; ++kk) { const LAS unsigned char* vp = lds + 36864 + (16 * et + r) * 528 + (32 * kk + 4 * q) * 2;
                const u32x2 lo = *(const LAS u32x2*)vp, hi = *(const LAS u32x2*)(vp + 32); const u32x4 w = {lo.x, lo.y, hi.x, hi.y};
                a = mfma16(__builtin_bit_cast(bf16x8, w), pf[kk], a); }
            o[et] = a; }
        if (valid) { const size_t pidx = ((size_t)slot * T + tokq) * 8 + h;
#pragma unroll
            for (int et = 0; et < 4; ++et) { u32x2 w; w.x = pk2(o[et][0], o[et][1]); w.y = pk2(o[et][2], o[et][3]); *(u32x2*)(PO + pidx * 64 + 16 * et + 4 * q) = w; }
            if (q == 0) *(f32x2_t*)(PML + pidx * 2) = (f32x2_t){m, l}; }
        __syncthreads();
    }
}
DI void combine_phase(const bf16_t* PO, const float* PML, bf16_t* Y, int gtid, int nth) {
    for (int idx = gtid; idx < T * 64; idx += nth) {
        const int e8 = idx & 7, th = idx >> 3, tok = th >> 3, h = th & 7;
        const int own = (tok & 8191) >> 8, nsel = own < 3 ? own : 3;
        const f32x2_t ml3 = *(const f32x2_t*)(PML + ((size_t)3 * T * 8 + th) * 2);
        float M = ml3.x, ms[3], ls[3];
#pragma unroll
        for (int s = 0; s < 3; ++s) { ms[s] = -INFINITY; ls[s] = 0.f; if (s < nsel) { const f32x2_t ml = *(const f32x2_t*)(PML + ((size_t)s * T * 8 + th) * 2); ms[s] = ml.x; ls[s] = ml.y; M = fmaxf(M, ml.x); } }
        float acc[8];
        { const float w3 = exp2f(ml3.x - M); const u32x4 w = *(const u32x4*)(PO + ((size_t)3 * T * 8 + th) * 64 + e8 * 8);
          acc[0] = w3 * bflo(w.x); acc[1] = w3 * bfhi(w.x); acc[2] = w3 * bflo(w.y); acc[3] = w3 * bfhi(w.y); acc[4] = w3 * bflo(w.z); acc[5] = w3 * bfhi(w.z); acc[6] = w3 * bflo(w.w); acc[7] = w3 * bfhi(w.w);
          float den = w3 * ml3.y;
#pragma unroll
          for (int s = 0; s < 3; ++s) if (s < nsel) { const float ww = exp2f(ms[s] - M); den += ww * ls[s]; const u32x4 x = *(const u32x4*)(PO + ((size_t)s * T * 8 + th) * 64 + e8 * 8);
              acc[0] += ww * bflo(x.x); acc[1] += ww * bfhi(x.x); acc[2] += ww * bflo(x.y); acc[3] += ww * bfhi(x.y); acc[4] += ww * bflo(x.z); acc[5] += ww * bfhi(x.z); acc[6] += ww * bflo(x.w); acc[7] += ww * bfhi(x.w); }
          const float inv = 1.f / den;
          u32x4 o; o.x = pk2(acc[0] * inv, acc[1] * inv); o.y = pk2(acc[2] * inv, acc[3] * inv); o.z = pk2(acc[4] * inv, acc[5] * inv); o.w = pk2(acc[6] * inv, acc[7] * inv);
          *(u32x4*)(Y + (size_t)tok * DM + 512 + h * 64 + e8 * 8) = o; }
    }
}

DI void retkv_phase(const bf16_t* P1, const bf16_t* VT, float* KV, int gw, int ngw, int lane) {
    const int r = lane & 15, q = lane >> 4;
    for (int u = gw; u < 2048; u += ngw) {
        const int bh = u >> 6, n = u & 63, b = bh >> 3, h = bh & 7; const size_t tok0 = (size_t)b * SEQ + n * 128; const float lg = LGAM[h];
        f32x4 acc[4][4];
#pragma unroll
        for (int et = 0; et < 4; ++et)
#pragma unroll
            for (int dt = 0; dt < 4; ++dt) acc[et][dt] = (f32x4){0.f, 0.f, 0.f, 0.f};
#pragma unroll 1
        for (int ks = 0; ks < 4; ++ks) {
            bf16x8 af[4], bfr[4];
#pragma unroll
            for (int et = 0; et < 4; ++et) af[et] = *(const bf16x8*)(VT + (size_t)(h * 64 + 16 * et + r) * T + tok0 + 32 * ks + 8 * q);
            float z[8];
#pragma unroll
            for (int i = 0; i < 8; ++i) z[i] = expf(lg * (float)(127 - (32 * ks + 8 * q + i)));
#pragma unroll
            for (int dt = 0; dt < 4; ++dt) { const bf16_t* kp = P1 + (tok0 + 32 * ks + 8 * q) * P1C + OFF_KA + h * 64 + 16 * dt + r; float f[8];
#pragma unroll
                for (int i = 0; i < 8; ++i) f[i] = bf2f(kp[(size_t)i * P1C]) * z[i];
                bfr[dt] = pack8(f[0], f[1], f[2], f[3], f[4], f[5], f[6], f[7]); }
#pragma unroll
            for (int et = 0; et < 4; ++et)
#pragma unroll
                for (int dt = 0; dt < 4; ++dt) acc[et][dt] = mfma16(af[et], bfr[dt], acc[et][dt]);
        }
        float* o = KV + (size_t)u * 4096;
#pragma unroll
        for (int et = 0; et < 4; ++et)
#pragma unroll
            for (int dt = 0; dt < 4; ++dt)
#pragma unroll
                for (int s = 0; s < 4; ++s) o[(16 * et + 4 * q + s) * 64 + 16 * dt + r] = acc[et][dt][s] * 0.125f;
    }
}
DI void scan_phase(float* KV, int gtid, int nth) {
    for (int idx = gtid; idx < 32 * 4096; idx += nth) { const int bh = idx >> 12, el = idx & 4095, h = bh & 7; const float cd = expf(LGAM[h] * 128.f);
        float st = 0.f; float* p = KV + (size_t)bh * 64 * 4096 + el;
        for (int n = 0; n < 64; ++n) { const float t = p[(size_t)n * 4096]; p[(size_t)n * 4096] = st; st = st * cd + t; } }
}
DI void retout_phase(const bf16_t* P1, const bf16_t* VT, const float* KV, const float* gn, bf16_t* Y, int gw, int ngw, int lane) {
    const int r = lane & 15, q = lane >> 4;
    for (int u = gw; u < 2048; u += ngw) {
        const int bh = u >> 6, n = u & 63, b = bh >> 3, h = bh & 7; const size_t tok0 = (size_t)b * SEQ + n * 128; const float lg = LGAM[h];
        const float* St = KV + (size_t)u * 4096;
        bf16x8 sa[4][2];
#pragma unroll
        for (int et = 0; et < 4; ++et)
#pragma unroll
            for (int ks = 0; ks < 2; ++ks) { const float* p = St + (16 * et + r) * 64 + ks * 32 + q * 8; sa[et][ks] = pack44(*(const f32x4*)p, *(const f32x4*)(p + 4)); }
#pragma unroll 1
        for (int it = 0; it < 8; ++it) {
            const size_t tq = tok0 + 16 * it + r; const int iq = 16 * it + r;
            bf16x8 bq[2];
#pragma unroll
            for (int ks = 0; ks < 2; ++ks) bq[ks] = *(const bf16x8*)(P1 + tq * P1C + OFF_QA + h * 64 + ks * 32 + q * 8);
            f32x4 st[8];
#pragma unroll
            for (int jt = 0; jt < 8; ++jt) { f32x4 a = {0.f, 0.f, 0.f, 0.f};
                if (jt <= it) {
#pragma unroll
                    for (int ks = 0; ks < 2; ++ks) { const bf16x8 ka = *(const bf16x8*)(P1 + (tok0 + 16 * jt + r) * P1C + OFF_KA + h * 64 + ks * 32 + q * 8); a = mfma16(ka, bq[ks], a); }
#pragma unroll
                    for (int s = 0; s < 4; ++s) { const int df = iq - (16 * jt + 4 * q + s); a[s] = df >= 0 ? a[s] * 0.125f * expf(lg * (float)df) : 0.f; } }
                st[jt] = a; }
            f32x4 oi[4], oc[4];
#pragma unroll
            for (int et = 0; et < 4; ++et) { f32x4 a = {0.f, 0.f, 0.f, 0.f};
#pragma unroll
                for (int kk = 0; kk < 4; ++kk) if (2 * kk <= it) { const bf16_t* vp = VT + (size_t)(h * 64 + 16 * et + r) * T + tok0 + 32 * kk + 4 * q;
                    const u32x2 lo = *(const u32x2*)vp, hi = *(const u32x2*)(vp + 16); const u32x4 w = {lo.x, lo.y, hi.x, hi.y};
                    a = mfma16(__builtin_bit_cast(bf16x8, w), pack44(st[2 * kk], st[2 * kk + 1]), a); }
                oi[et] = a;
                f32x4 c = {0.f, 0.f, 0.f, 0.f};
#pragma unroll
                for (int ks = 0; ks < 2; ++ks) c = mfma16(sa[et][ks], bq[ks], c);
                oc[et] = c; }
            const float xi = expf(lg * (float)(iq + 1));
            float sum = 0.f;
#pragma unroll
            for (int et = 0; et < 4; ++et) { oi[et] = oi[et] + oc[et] * xi; sum += (oi[et][0] + oi[et][1]) + (oi[et][2] + oi[et][3]); }
            sum += __shfl_xor(sum, 16); sum += __shfl_xor(sum, 32);
            const float mu = sum * (1.f / 64.f); float sq = 0.f;
#pragma unroll
            for (int et = 0; et < 4; ++et) { oi[et] = oi[et] - mu; sq += (oi[et][0] * oi[et][0] + oi[et][1] * oi[et][1]) + (oi[et][2] * oi[et][2] + oi[et][3] * oi[et][3]); }
            sq += __shfl_xor(sq, 16); sq += __shfl_xor(sq, 32);
            const float rstd = 1.f / sqrtf(sq * (1.f / 64.f) + LN_EPS);
#pragma unroll
            for (int et = 0; et < 4; ++et) { const int e0 = h * 64 + 16 * et + 4 * q;
                const u32x2 gw2 = *(const u32x2*)(P1 + tq * P1C + OFF_GA + e0); const f32x4 gg = *(const f32x4*)(gn + e0);
                const float g0 = bflo(gw2.x), g1 = bfhi(gw2.x), g2 = bflo(gw2.y), g3 = bfhi(gw2.y);
                const float y0 = oi[et][0] * rstd * gg[0] * silu(g0), y1 = oi[et][1] * rstd * gg[1] * silu(g1), y2 = oi[et][2] * rstd * gg[2] * silu(g2), y3 = oi[et][3] * rstd * gg[3] * silu(g3);
                u32x2 w; w.x = pk2(y0, y1); w.y = pk2(y2, y3); *(u32x2*)(Y + tq * DM + e0) = w; }
        }
    }
}

DI void sgu_phase(const bf16_t* VT2, const bf16_t* HU, const float* VST, const float* wsl, const float* bsl, const float* lng, const float* lnb, bf16_t* SG, LAS unsigned char* lds, int gw, int ngw, int wave, int lane) {
    const int r = lane & 15, q = lane >> 4;
    LAS f32x2_t* stl = (LAS f32x2_t*)(lds + wave * 1024);
    for (int u = gw; u < 2048; u += ngw) {
        const int c = u >> 3, g = u & 7; const size_t tok0 = (size_t)c * 128;
#pragma unroll
        for (int tt = 0; tt < 2; ++tt) { const int tk = lane + 64 * tt; const f32x4* p = (const f32x4*)(VST + (tok0 + tk) * 32); float S = 0.f, Q = 0.f;
#pragma unroll
            for (int k = 0; k < 8; ++k) { const f32x4 v = p[k]; S += v[0] + v[2]; Q += v[1] + v[3]; }
            const float mean = S * (1.f / 2048.f), var = Q * (1.f / 2048.f) - mean * mean;
            stl[tk] = (f32x2_t){mean, 1.f / sqrtf(var + LN_EPS)}; }
        LDS_WAIT();
        const float* wsg = wsl + (size_t)g * 128 * 128;
        bf16x8 wf[8][4];
#pragma unroll
        for (int it = 0; it < 8; ++it)
#pragma unroll
            for (int ks = 0; ks < 4; ++ks) if (ks <= (it >> 1)) { const int i = 16 * it + r, j0 = 32 * ks + 8 * q; const float* p = wsg + (size_t)i * 128 + j0;
                const f32x4 a = *(const f32x4*)p, bb = *(const f32x4*)(p + 4); float f[8];
#pragma unroll
                for (int jj = 0; jj < 4; ++jj) { f[jj] = (j0 + jj <= i) ? a[jj] : 0.f; f[4 + jj] = (j0 + 4 + jj <= i) ? bb[jj] : 0.f; }
                wf[it][ks] = pack8(f[0], f[1], f[2], f[3], f[4], f[5], f[6], f[7]); }
        for (int ct = 0; ct < 16; ++ct) {
            const int f = g * 256 + 16 * ct + r; const float gain = lng[f], bias = lnb[f];
            bf16x8 af[4];
#pragma unroll
            for (int ks = 0; ks < 4; ++ks) { const u32x4 w = *(const u32x4*)(VT2 + (size_t)f * T + tok0 + 32 * ks + 8 * q); const LAS f32x4* sp = (const LAS f32x4*)(stl + 32 * ks + 8 * q);
                const f32x4 s0 = sp[0], s1 = sp[1], s2 = sp[2], s3 = sp[3];
                af[ks] = pack8((bflo(w.x) - s0[0]) * s0[1] * gain + bias, (bfhi(w.x) - s0[2]) * s0[3] * gain + bias, (bflo(w.y) - s1[0]) * s1[1] * gain + bias, (bfhi(w.y) - s1[2]) * s1[3] * gain + bias,
                               (bflo(w.z) - s2[0]) * s2[1] * gain + bias, (bfhi(w.z) - s2[2]) * s2[3] * gain + bias, (bflo(w.w) - s3[0]) * s3[1] * gain + bias, (bfhi(w.w) - s3[2]) * s3[3] * gain + bias); }
#pragma unroll
            for (int it = 0; it < 8; ++it) { f32x4 a = {0.f, 0.f, 0.f, 0.f};
#pragma unroll
                for (int ks = 0; ks < 4; ++ks) if (ks <= (it >> 1)) a = mfma16(af[ks], wf[it][ks], a);
                const size_t tok = tok0 + 16 * it + r; const int feat = g * 256 + 16 * ct + 4 * q; const float bsi = bsl[g * 128 + 16 * it + r];
                const u32x2 uu = *(const u32x2*)(HU + tok * 2048 + feat);
                u32x2 w; w.x = pk2((a[0] + bsi) * bflo(uu.x), (a[1] + bsi) * bfhi(uu.x)); w.y = pk2((a[2] + bsi) * bflo(uu.y), (a[3] + bsi) * bfhi(uu.y));
                *(u32x2*)(SG + tok * 2048 + feat) = w; }
        }
        LDS_WAIT();
    }
}

struct Args { const float* in[16]; float* out; unsigned char* ws; int ph_lo, ph_hi; };
__global__ void __launch_bounds__(512, 2) mega_fwd(Args args) {
    extern __shared__ __attribute__((aligned(16))) unsigned char lds_raw[];
    LAS unsigned char* lds = (LAS unsigned char*)lds_raw;
    cg::grid_group grid = cg::this_grid();
    const int G = gridDim.x, bx = blockIdx.x, ngw = G * 8, nth = G * 512;
    const int lo = args.ph_lo, hi = args.ph_hi;
#define xf (args.out)
#define cnt ((unsigned*)(args.ws + WS_CTL))
#define Wb ((bf16_t*)(args.ws + WS_W))
#define cs ((float*)(args.ws + WS_CS))
#define sn ((float*)(args.ws + WS_SN))
#define xb ((bf16_t*)(args.ws + WS_XB))
#define P1 ((bf16_t*)(args.ws + WS_P1))
#define VT ((bf16_t*)(args.ws + WS_VT))
#define PO ((bf16_t*)(args.ws + WS_PO))
#define PML ((float*)(args.ws + WS_PML))
#define KV ((float*)(args.ws + WS_KV))
#define lst ((unsigned short*)(args.ws + WS_LST))
#define KM ((float*)(args.ws + WS_KM))
#define HB ((bf16_t*)(args.ws + WS_H))
#define HU ((bf16_t*)(args.ws + WS_HU))
#define VT2 ((bf16_t*)(args.ws + WS_VT2))
#define SG ((bf16_t*)(args.ws + WS_SG))
#define VST ((float*)(args.ws + WS_VST))
#define Y xb
    int ph = 0;
#define PH_BEGIN if (ph >= lo && ph < hi) { int tid = threadIdx.x; asm volatile("" : "+v"(tid)); const int lane = tid & 63, wave = __builtin_amdgcn_readfirstlane(tid >> 6), gw = bx * 8 + wave, gtid = bx * 512 + tid; (void)lane; (void)gw; (void)gtid;
#define PH_END   if (ph + 1 < hi) grid.sync(); } ++ph;
#define GEMM(EPI, g_, S_, E_) pg8::gemm_phase<EPI, pg8::StaticOrder, true, true>(lds, g_, S_, E_)

    PH_BEGIN
        if (EN(0)) phase0(args.in[0], (const int*)args.in[1], xf, xb, cs, sn, gtid, nth);
        if (EN(0)) conv_weights(args.in, 0, Wb, lds, gw, ngw, wave, lane);
    PH_END
    for (int layer = 0; layer < 4; ++layer) {
        const int li = layer >> 1; const bool even = !(layer & 1);
        if (even) {
            PH_BEGIN
                if (bx == 0) for (int i = tid; i < 1024; i += 512) cnt[i] = 0u;
                if (EN(1)) { pg8::Gemm g{xb, Wb + WE_A, T, 2560, 1024}; pg8::StaticOrder S; S.init(T, 2560, G, bx); EpiRope E{P1, P1C, cs, sn, 8}; GEMM(EpiRope, g, S, E); }
                if (EN(2)) { pg8::Gemm g{Wb + WE_A + (size_t)2560 * 1024, xb, 1024, T, 1024}; pg8::StaticOrder S; S.init(1024, T, G, bx); EpiAct<0> E{VT, T, nullptr}; GEMM(EpiAct<0>, g, S, E); }
            PH_END
            PH_BEGIN
                if (EN(3)) kmean_phase(P1, KM, gw, ngw, lane);
                if (EN(4)) retkv_phase(P1, VT, KV, gw, ngw, lane);
            PH_END
            PH_BEGIN
                if (EN(5)) gate_phase(P1, KM, cnt, lst, gw, ngw, lane);
                if (EN(6)) scan_phase(KV, gtid, nth);
            PH_END
            PH_BEGIN
                if (EN(7)) moba_phase(P1, VT, cnt, lst, PO, PML, lds, tid, wave, lane);
            PH_END
            PH_BEGIN
                if (EN(8)) combine_phase(PO, PML, Y, gtid, nth);
                if (EN(9)) retout_phase(P1, VT, KV, args.in[5] + (size_t)li * 512, Y, gw, ngw, lane);
            PH_END
        } else {
            PH_BEGIN
                if (EN(10)) { pg8::Gemm g{xb, Wb + WE_A, T, 2048, 1024}; pg8::StaticOrder S; S.init(T, 2048, G, bx); EpiAct<2> E{HU, 2048, args.in[8] + (size_t)li * 4096}; GEMM(EpiAct<2>, g, S, E); }
                if (EN(11)) { pg8::Gemm g{Wb + WE_A + (size_t)2048 * 1024, xb, 2048, T, 1024}; pg8::StaticOrder S; S.init(2048, T, G, bx); EpiVt E{VT2, args.in[8] + (size_t)li * 4096 + 2048, VST}; GEMM(EpiVt, g, S, E); }
            PH_END
            PH_BEGIN
                if (EN(12)) sgu_phase(VT2, HU, VST, args.in[11] + (size_t)li * 8 * 128 * 128, args.in[12] + (size_t)li * 8 * 128, args.in[9] + (size_t)li * 2048, args.in[10] + (size_t)li * 2048, SG, lds, gw, ngw, wave, lane);
            PH_END
        }
        PH_BEGIN
            if (EN(13)) { pg8::Gemm g{even ? Y : SG, Wb + WE_O, T, 1024, even ? 1024 : 2048}; pg8::StaticOrder S; S.init(T, 1024, G, bx); EpiRes E{xf}; GEMM(EpiRes, g, S, E); }
        PH_END
        PH_BEGIN
            if (EN(14)) ln_phase(xf, xb, args.in[2] + (size_t)(layer * 2 + 0) * DM, args.in[3] + (size_t)(layer * 2 + 0) * DM, gw, ngw, lane);
        PH_END
        PH_BEGIN
            if (EN(15)) { pg8::Gemm g{xb, Wb + WE_1, T, 4096, 1024}; pg8::StaticOrder S; S.init(T, 4096, G, bx); EpiAct<1> E{HB, 4096, nullptr}; GEMM(EpiAct<1>, g, S, E); }
        PH_END
        PH_BEGIN
            if (EN(16)) { pg8::Gemm g{HB, Wb + WE_2, T, 1024, 4096}; pg8::StaticOrder S; S.init(T, 1024, G, bx); EpiRes E{xf}; GEMM(EpiRes, g, S, E); }
        PH_END
        PH_BEGIN
            if (EN(14)) ln_phase(xf, xb, args.in[2] + (size_t)(layer * 2 + 1) * DM, args.in[3] + (size_t)(layer * 2 + 1) * DM, gw, ngw, lane);
            if (EN(0) && layer < 3) conv_weights(args.in, layer + 1, Wb, lds, gw, ngw, wave, lane);
        PH_END
    }
}

extern "C" void kernel_launch(void* const* d_in, const int* in_sizes, int n_in, void* d_out, int out_size, void* d_ws, size_t ws_size, hipStream_t stream) {
    static int grid = 0;
    if (grid == 0) {
        if (n_in != 16 || out_size != T * DM || ws_size < WS_NEED) { fprintf(stderr, "kernel_launch: unexpected shapes (n_in %d, out %d, ws %zu)\n", n_in, out_size, ws_size); grid = -1; return; }
        int dev = 0, cus = 0, per_cu = 0;
        if (hipGetDevice(&dev) != hipSuccess || hipDeviceGetAttribute(&cus, hipDeviceAttributeMultiprocessorCount, dev) != hipSuccess) { grid = -1; return; }
        if (hipFuncSetAttribute((const void*)mega_fwd, hipFuncAttributeMaxDynamicSharedMemorySize, LDS_BYTES) != hipSuccess) { fprintf(stderr, "kernel_launch: hipFuncSetAttribute failed\n"); grid = -1; return; }
        if (hipOccupancyMaxActiveBlocksPerMultiprocessor(&per_cu, (const void*)mega_fwd, 512, LDS_BYTES) != hipSuccess || per_cu < 1) per_cu = 1;
        (void)hipGetLastError();
        grid = cus * per_cu;
        fprintf(stderr, "kernel_launch: grid %d (%d CUs x %d)\n", grid, cus, per_cu);
    }
    if (grid < 0) return;
    Args a{};
    for (int i = 0; i < 16; ++i) a.in[i] = (const float*)d_in[i];
    a.out = (float*)d_out; a.ws = (unsigned char*)d_ws;
#if MK_MULTI
    for (int p = 0; p < N_PHASES; ++p) { a.ph_lo = p; a.ph_hi = p + 1; hipLaunchKernelGGL(mega_fwd, dim3(grid), dim3(512), LDS_BYTES, stream, a); }
#else
    a.ph_lo = 0; a.ph_hi = N_PHASES;
    void* params[] = {&a};
    const hipError_t e = hipLaunchCooperativeKernel((const void*)mega_fwd, dim3(grid), dim3(512), params, LDS_BYTES, stream);
    if (e != hipSuccess) fprintf(stderr, "kernel_launch: cooperative launch failed: %s (grid %d)\n", hipGetErrorString(e), grid);
#endif
}
```

```cpp
#include <hip/hip_runtime.h>
#include <hip/hip_cooperative_groups.h>
#include <cstdio>
#include <cstdint>
#include <cmath>
namespace cg = cooperative_groups;
#ifndef MK_MULTI
#define MK_MULTI 0
#endif

namespace pg8 {
#define PG8_LAS __attribute__((address_space(3)))
typedef unsigned short bf16_t;
typedef short bf16x8 __attribute__((ext_vector_type(8)));
typedef float f32x4 __attribute__((ext_vector_type(4)));
typedef unsigned u32x4 __attribute__((ext_vector_type(4)));
constexpr int BM = 256, BK = 64, HALF = 128, HTB = HALF * BK * 2  , STAGE_BYTES = 8 * HTB, NXCD = 8, WGM = 8;

__host__ __device__ __forceinline__ int lds_byte(int r, int c) { const int st = (r >> 4) * 2 + (c >> 5), rr = r & 15, cc = c & 31, ob = rr * 64 + cc * 2; return st * 1024 + (ob ^ (((ob >> 9) & 1) << 5)); }
__host__ __device__ __forceinline__ void stage_rc(int b, int& R, int& C) { const int st = b / 1024, sb = b % 1024, swz = sb ^ (((sb >> 9) & 1) << 5); R = (st >> 1) * 16 + swz / 64; C = (st & 1) * 32 + (swz % 64) / 2; }
__host__ __device__ __forceinline__ int perm32(int rho) { const int n = rho >> 4, i = rho & 15; return 8 * (i >> 2) + 4 * n + (i & 3); }

struct Unit { int pm, pn; };
struct Gemm { const bf16_t* A; const bf16_t* Bt; int M, N, K; };

struct StaticOrder {
    int nM, nN, nwg, G, c;
    __host__ __device__ void init(int M, int N, int G_, int c_) { nM = M / BM; nN = N / BM; nwg = nM * nN; G = G_; c = c_; }
    __host__ __device__ bool next(int i, Unit& u) const {
        const long L = (long)i * G + c; if (L >= nwg) return false;
        int wgid = (int)L; { const int q = nwg / NXCD, r = nwg % NXCD, xcd = wgid % NXCD, off = wgid / NXCD; wgid = (xcd < r ? xcd * (q + 1) : r * (q + 1) + (xcd - r) * q) + off; }
        const int nig = WGM * nN, gid = wgid / nig, fm = gid * WGM, gsz = (nM - fm) < WGM ? (nM - fm) : WGM;
        u.pm = fm + ((wgid % nig) % gsz); u.pn = (wgid % nig) / gsz; return true;
    }
    __device__ __forceinline__ void a_ready(const Unit&) const {}
    __device__ __forceinline__ void done(const Unit&) const {}
};

__device__ __forceinline__ unsigned cvt_pk_bf16(float lo, float hi) { unsigned r; asm volatile("v_cvt_pk_bf16_f32 %0, %1, %2" : "=v"(r) : "v"(lo), "v"(hi)); return r; }
typedef float f32x2 __attribute__((ext_vector_type(2)));
template <class Epi, class Sched, bool ALIGN_EPI = false, bool SP2 = false>
__device__ __forceinline__ void gemm_phase(PG8_LAS unsigned char* lds, const Gemm g, const Sched& S, const Epi& E) {
    int tid_o = threadIdx.x; asm volatile("" : "+v"(tid_o));
    const int tid = tid_o, wid = __builtin_amdgcn_readfirstlane(tid >> 6), lane = tid & 63, wr = wid >> 2, wc = wid & 3, fr = lane & 15, fq = lane >> 4;
    const int K = g.K, nt = K / BK;
    unsigned voffA[2], voffB[2];
#pragma unroll
    for (int i = 0; i < 2; ++i) { int R, C; stage_rc(tid * 16 + i * 8192, R, C); const int Rb = Epi::PERM ? ((R & ~31) + perm32(R & 31)) : R;
        voffA[i] = (unsigned)(R * K + C) * 2u; voffB[i] = (unsigned)(Rb * K + C) * 2u; }
    const size_t kstep = (size_t)(BK * 2);
    const size_t hstep = (size_t)HALF * K * 2;
    const size_t tstep = 2 * hstep;
    const unsigned ldsw = (unsigned)wid * 1024u;
    const int aoff = lds_byte(wr * 64 + fr, fq * 8), boff = lds_byte(wc * 32 + fr, fq * 8);
#define PG8_SA(b, h) (((b) * 2 + (h)) * HTB)
#define PG8_SB(b, h) ((4 + (b) * 2 + (h)) * HTB)
#define PG8_STAGE(bufoff, gbase, voff) do { _Pragma("unroll") for (int _i = 0; _i < 2; ++_i) \
        __builtin_amdgcn_global_load_lds((const unsigned*)((const char*)(gbase) + (voff)[_i]), (PG8_LAS unsigned*)(lds + (bufoff) + ldsw + _i * 8192), 16, 0, 0); } while (0)
#define PG8_LDA(dst, b, h) do { _Pragma("unroll") for (int m = 0; m < 4; ++m) _Pragma("unroll") for (int k = 0; k < 2; ++k) dst[m][k] = *(const PG8_LAS bf16x8*)(lds + PG8_SA(b, h) + aoff + m * 2048 + k * 1024); } while (0)
#define PG8_LDB(dst, b, h) do { _Pragma("unroll") for (int n = 0; n < 2; ++n) _Pragma("unroll") for (int k = 0; k < 2; ++k) dst[n][k] = *(const PG8_LAS bf16x8*)(lds + PG8_SB(b, h) + boff + n * 2048 + k * 1024); } while (0)
#define PG8_MMA(ai, bj, At, Bt) do { __builtin_amdgcn_s_setprio(1); _Pragma("unroll") for (int m = 0; m < 4; ++m) _Pragma("unroll") for (int n = 0; n < 2; ++n) _Pragma("unroll") for (int k = 0; k < 2; ++k) \
        acc[ai][bj][m][n] = __builtin_amdgcn_mfma_f32_16x16x32_bf16(Bt[n][k], At[m][k], acc[ai][bj][m][n], 0, 0, 0); __builtin_amdgcn_s_setprio(0); } while (0)
#define PG8_WAIT_V(n) asm volatile("s_waitcnt vmcnt(" #n ")" ::: "memory")
#define PG8_WAIT_L(n) asm volatile("s_waitcnt lgkmcnt(" #n ")" ::: "memory")
#define PG8_BAR __builtin_amdgcn_s_barrier()
#define PG8_SCHED __builtin_amdgcn_sched_barrier(0)
    Unit cur, nxt; int ui = 0;
    if (!S.next(0, cur)) return;
    f32x4 acc[2][2][4][2];
#pragma unroll
    for (int a = 0; a < 2; ++a)
#pragma unroll
        for (int b = 0; b < 2; ++b)
#pragma unroll
            for (int m = 0; m < 4; ++m)
#pragma unroll
                for (int n = 0; n < 2; ++n) acc[a][b][m][n] = (f32x4){0.f, 0.f, 0.f, 0.f};
    bf16x8 At[4][2], B0[2][2], B1[2][2];
    const char* cA = (const char*)g.A + (size_t)cur.pm * tstep; const char* cB = (const char*)g.Bt + (size_t)cur.pn * tstep;
    S.a_ready(cur);
    if constexpr (SP2) {
        PG8_STAGE(PG8_SB(0, 0), cB, voffB); PG8_STAGE(PG8_SB(0, 1), cB + hstep, voffB); PG8_STAGE(PG8_SA(0, 0), cA, voffA); PG8_STAGE(PG8_SA(0, 1), cA + hstep, voffA);
        if (wr == 1) PG8_BAR;
        PG8_WAIT_V(2); PG8_BAR;
        PG8_STAGE(PG8_SB(1, 0), cB + kstep, voffB); PG8_STAGE(PG8_SA(1, 0), cA + kstep, voffA); PG8_STAGE(PG8_SB(1, 1), cB + hstep + kstep, voffB);
        PG8_WAIT_V(6); PG8_BAR;
    } else {
        PG8_STAGE(PG8_SB(0, 0), cB, voffB); PG8_STAGE(PG8_SA(0, 0), cA, voffA); PG8_STAGE(PG8_SB(0, 1), cB + hstep, voffB); PG8_STAGE(PG8_SA(0, 1), cA + hstep, voffA);
        if (wr == 1) PG8_BAR;
        PG8_WAIT_V(4); PG8_BAR;
        PG8_STAGE(PG8_SB(1, 0), cB + kstep, voffB); PG8_STAGE(PG8_SA(1, 0), cA + kstep, voffA); PG8_STAGE(PG8_SB(1, 1), cB + hstep + kstep, voffB);
        PG8_WAIT_V(6); PG8_BAR;
    }
    for (;;) {
        const bool has_next = S.next(ui + 1, nxt);
        const char* nA = has_next ? (const char*)g.A + (size_t)nxt.pm * tstep : cA; const char* nB = has_next ? (const char*)g.Bt + (size_t)nxt.pn * tstep : cB;
        for (int t = 0; t < nt; t += 2) {
            const bool last = (t == nt - 2);
            const char* a1 = cA + (size_t)(t + 1) * kstep;
            const char* a2 = last ? nA : cA + (size_t)(t + 2) * kstep; const char* b2 = last ? nB : cB + (size_t)(t + 2) * kstep;
            const char* a3 = a2 + kstep; const char* b3 = b2 + kstep;
            if (last && has_next) S.a_ready(nxt);
            if constexpr (SP2) {
            PG8_LDB(B0, 0, 0); PG8_LDB(B1, 0, 1); PG8_SCHED; PG8_LDA(At, 0, 0); PG8_STAGE(PG8_SA(1, 1), a1 + hstep, voffA);
            PG8_WAIT_V(8); PG8_WAIT_L(0); PG8_BAR; PG8_MMA(0, 0, At, B0); PG8_MMA(0, 1, At, B1); PG8_BAR; PG8_SCHED;
            PG8_LDA(At, 0, 1); PG8_STAGE(PG8_SB(0, 0), b2, voffB); PG8_STAGE(PG8_SB(0, 1), b2 + hstep, voffB); PG8_STAGE(PG8_SA(0, 0), a2, voffA);
            PG8_WAIT_V(8); PG8_WAIT_L(0); PG8_BAR; PG8_MMA(1, 0, At, B0); PG8_MMA(1, 1, At, B1); PG8_BAR; PG8_SCHED;
            PG8_LDB(B0, 1, 0); PG8_LDB(B1, 1, 1); PG8_SCHED; PG8_LDA(At, 1, 0); PG8_STAGE(PG8_SA(0, 1), a2 + hstep, voffA);
            PG8_WAIT_V(8); PG8_WAIT_L(0); PG8_BAR; PG8_MMA(0, 0, At, B0); PG8_MMA(0, 1, At, B1); PG8_BAR; PG8_SCHED;
            PG8_LDA(At, 1, 1); PG8_STAGE(PG8_SB(1, 0), b3, voffB); PG8_STAGE(PG8_SB(1, 1), b3 + hstep, voffB); PG8_STAGE(PG8_SA(1, 0), a3, voffA);
            PG8_WAIT_V(8); PG8_WAIT_L(0); PG8_BAR; PG8_MMA(1, 0, At, B0); PG8_MMA(1, 1, At, B1); PG8_BAR; PG8_SCHED;
            } else {
            PG8_LDB(B0, 0, 0); PG8_SCHED; PG8_LDA(At, 0, 0); PG8_STAGE(PG8_SA(1, 1), a1 + hstep, voffA);
            PG8_WAIT_L(8); PG8_BAR; PG8_WAIT_L(0); PG8_MMA(0, 0, At, B0); PG8_BAR; PG8_SCHED;
            PG8_LDB(B1, 0, 1); PG8_STAGE(PG8_SB(0, 0), b2, voffB);
            PG8_BAR; PG8_WAIT_L(0); PG8_MMA(0, 1, At, B1); PG8_BAR;
            PG8_LDA(At, 0, 1); PG8_STAGE(PG8_SA(0, 0), a2, voffA);
            PG8_BAR; PG8_WAIT_L(0); PG8_MMA(1, 0, At, B0); PG8_BAR; PG8_SCHED;
            PG8_STAGE(PG8_SB(0, 1), b2 + hstep, voffB);
            PG8_WAIT_V(6); PG8_BAR; PG8_MMA(1, 1, At, B1); PG8_BAR;
            PG8_LDB(B0, 1, 0); PG8_SCHED; PG8_LDA(At, 1, 0); PG8_STAGE(PG8_SA(0, 1), a2 + hstep, voffA);
            PG8_WAIT_L(8); PG8_BAR; PG8_WAIT_L(0); PG8_MMA(0, 0, At, B0); PG8_BAR; PG8_SCHED;
            PG8_LDB(B1, 1, 1); PG8_STAGE(PG8_SB(1, 0), b3, voffB);
            PG8_BAR; PG8_WAIT_L(0); PG8_MMA(0, 1, At, B1); PG8_BAR;
            PG8_LDA(At, 1, 1); PG8_STAGE(PG8_SA(1, 0), a3, voffA);
            PG8_BAR; PG8_WAIT_L(0); PG8_MMA(1, 0, At, B0); PG8_BAR; PG8_SCHED;
            PG8_STAGE(PG8_SB(1, 1), b3 + hstep, voffB);
            PG8_WAIT_V(6); PG8_BAR; PG8_MMA(1, 1, At, B1); PG8_BAR;
            }
        }
        if constexpr (ALIGN_EPI) { if (wr == 0) PG8_BAR; }
        if constexpr (!Epi::AFTER_DRAIN) { E(acc, cur, wr, wc, fr, fq); S.done(cur); }
        if (!has_next) break;
#pragma unroll
        for (int a = 0; a < 2; ++a)
#pragma unroll
            for (int b = 0; b < 2; ++b)
#pragma unroll
                for (int m = 0; m < 4; ++m)
#pragma unroll
                    for (int n = 0; n < 2; ++n) acc[a][b][m][n] = (f32x4){0.f, 0.f, 0.f, 0.f};
        cur = nxt; cA = nA; cB = nB; ++ui;
        if constexpr (ALIGN_EPI) { if (wr == 1) PG8_BAR; }
    }
    PG8_WAIT_V(0);
    if constexpr (!ALIGN_EPI) { if (wr == 0) PG8_BAR; }
    PG8_BAR;
    if constexpr (Epi::AFTER_DRAIN) { E.fused(acc, cur, wr, wc, fr, fq, lds, wid, lane); S.done(cur); }
#undef PG8_SA
#undef PG8_SB
#undef PG8_STAGE
#undef PG8_LDA
#undef PG8_LDB
#undef PG8_MMA
#undef PG8_WAIT_V
#undef PG8_WAIT_L
#undef PG8_BAR
#undef PG8_SCHED
}
}
using pg8::bf16_t; using pg8::bf16x8; using pg8::f32x4; using pg8::u32x4; using pg8::Unit;
#define DI __device__ __forceinline__
#define LAS __attribute__((address_space(3)))
typedef float f32x2_t __attribute__((ext_vector_type(2)));
typedef __bf16 bf16x2_t __attribute__((ext_vector_type(2)));
typedef unsigned u32x2 __attribute__((ext_vector_type(2)));

constexpr int T = 32768, SEQ = 8192, DM = 1024;
constexpr int P1C = 2560;
constexpr int OFF_QA = 0, OFF_KA = 512, OFF_QB = 1024, OFF_KB = 1536, OFF_GA = 2048;
constexpr float ALPHA = 1.6817928305074292f, LN_EPS = 1e-5f;
constexpr size_t MiB = 1u << 20;
constexpr size_t WS_CTL = 0, WS_W = 1 * MiB, WS_CS = 29 * MiB, WS_SN = 33 * MiB, WS_XB = 37 * MiB, WS_BIG = 101 * MiB;
constexpr size_t WS_P1 = WS_BIG, WS_VT = WS_BIG + 160 * MiB, WS_PO = WS_BIG + 224 * MiB, WS_PML = WS_BIG + 352 * MiB, WS_KV = WS_BIG + 360 * MiB, WS_LST = WS_BIG + 392 * MiB, WS_KM = WS_BIG + 401 * MiB;
constexpr size_t WS_H = WS_BIG, WS_HU = WS_BIG, WS_VT2 = WS_BIG + 128 * MiB, WS_SG = WS_BIG + 256 * MiB, WS_VST = WS_BIG + 384 * MiB;
constexpr size_t WS_NEED = 512 * MiB;
constexpr size_t WS_BAR = 65536, BAR_BYTES = 16384;
constexpr size_t WE_A = 0, WE_O = (size_t)4 << 20, WE_1 = (size_t)6 << 20, WE_2 = (size_t)10 << 20;
constexpr int LDS_BYTES = 147456;
constexpr int LCAP = 126976;
constexpr int N_PHASES = 35;
#ifndef PM
#define PM 0x1ffff
#endif
#define EN(k) (((PM) >> (k)) & 1)
#ifndef RPM
#define RPM 0
#endif
#ifndef XSYNC
#define XSYNC 0
#endif
#define RP(k) for (int rep_ = 0; rep_ < (EN(k) ? 1 + (((RPM) >> (k)) & 1) : 0); ++rep_)

__device__ const float INVF[32] = {1.000000000e+00f, 7.498942614e-01f, 5.623413324e-01f, 4.216965139e-01f, 3.162277639e-01f, 2.371373773e-01f, 1.778279394e-01f, 1.333521307e-01f, 1.000000015e-01f, 7.498941571e-02f, 5.623413250e-02f, 4.216965288e-02f, 3.162277490e-02f, 2.371373773e-02f, 1.778279431e-02f, 1.333521493e-02f, 9.999999776e-03f, 7.498941850e-03f, 5.623413250e-03f, 4.216964822e-03f, 3.162277630e-03f, 2.371373586e-03f, 1.778279431e-03f, 1.333521446e-03f, 1.000000047e-03f, 7.498942432e-04f, 5.623413017e-04f, 4.216965172e-04f, 3.162277571e-04f, 2.371373703e-04f, 1.778279402e-04f, 1.333521504e-04f};
__device__ const float LGAM[8] = {-3.174869716e-02f, -1.574835740e-02f, -7.843177766e-03f, -3.913899418e-03f, -1.955034910e-03f, -9.770396864e-04f, -4.884005175e-04f, -2.441704273e-04f};

DI unsigned pk2(float lo, float hi) { f32x2_t v = {lo, hi}; bf16x2_t b = __builtin_convertvector(v, bf16x2_t); return __builtin_bit_cast(unsigned, b); }
DI float bflo(unsigned w) { return __uint_as_float(w << 16); }
DI float bfhi(unsigned w) { return __uint_as_float(w & 0xffff0000u); }
DI float bf2f(bf16_t h) { return __uint_as_float((unsigned)h << 16); }
DI bf16x8 pack8(float a0, float a1, float a2, float a3, float a4, float a5, float a6, float a7) { u32x4 w = {pk2(a0, a1), pk2(a2, a3), pk2(a4, a5), pk2(a6, a7)}; return __builtin_bit_cast(bf16x8, w); }
DI bf16x8 pack44(f32x4 a, f32x4 b) { return pack8(a[0], a[1], a[2], a[3], b[0], b[1], b[2], b[3]); }
DI f32x4 mfma16(bf16x8 a, bf16x8 b, f32x4 c) { return __builtin_amdgcn_mfma_f32_16x16x32_bf16(a, b, c, 0, 0, 0); }
DI float wave_sum(float v) {
#pragma unroll
    for (int o = 1; o < 64; o <<= 1) v += __shfl_xor(v, o);
    return v;
}
DI float gelu_tanh(float x) { const float u = 0.7978845608028654f * (x + 0.044715f * x * x * x); return x * __builtin_amdgcn_rcpf(1.f + __expf(-2.f * u)); }
DI float relu2(float x) { const float r = fmaxf(x, 0.f); return r * r; }
DI float silu(float x) { return x * __builtin_amdgcn_rcpf(1.f + __expf(-x)); }
#define LDS_WAIT() asm volatile("s_waitcnt lgkmcnt(0)" ::: "memory")
#define XB_TMO      128
#define XB_XCNT(j)  (256  + 64 * (j))
#define XB_XSUB(j)  (1280 + 64 * (j))
#define XB_XGEN(j)  (2304 + 64 * (j))
#define XB_TOP      3328
#define XB_TOPGEN   3392
#define XCD_BAR_WORDS 3456
#define XB_SPIN_CAP (1u << 18)

__device__ __forceinline__ unsigned xb_ld(unsigned* p)              { return __hip_atomic_load(p, __ATOMIC_RELAXED, __HIP_MEMORY_SCOPE_AGENT); }
__device__ __forceinline__ unsigned xb_add(unsigned* p, unsigned v) { return __hip_atomic_fetch_add(p, v, __ATOMIC_RELAXED, __HIP_MEMORY_SCOPE_AGENT); }
__device__ __forceinline__ unsigned xb_xcc_id() { return (unsigned)__builtin_amdgcn_s_getreg((3 << 11) | 20) & 0xFu; }
#define XB_SPIN(cond, bar) do { unsigned _sp = 0; while (cond) { __builtin_amdgcn_s_sleep(1); \
    if ((++_sp & 255u) == 0u) { if (xb_ld(&(bar)[XB_TMO])) break; if (_sp > XB_SPIN_CAP) { atomicAdd(&(bar)[XB_TMO], 1u); break; } } } } while (0)

struct XcdBarrier {
    unsigned* bar; unsigned x;
    volatile LAS unsigned* st;
};

__device__ __forceinline__ XcdBarrier xcd_barrier_post(unsigned* bar, volatile LAS unsigned* st) {
    XcdBarrier b; b.bar = bar; b.x = xb_xcc_id(); b.st = st;
    if (threadIdx.x == 0) (void)xb_add(&bar[XB_XCNT(b.x)], 1u);
    return b;
}
__device__ __forceinline__ void xcd_barrier_complete(unsigned* bar, unsigned x, unsigned& nloc, unsigned& nx) {
    const unsigned G = gridDim.x * gridDim.y * gridDim.z;
    unsigned sum, cnt, mine, sp = 0u;
    for (;;) {
        sum = 0u; cnt = 0u; mine = 0u;
#pragma unroll
        for (unsigned j = 0; j < 16; ++j) { const unsigned c = xb_ld(&bar[XB_XCNT(j)]); sum += c; cnt += (c > 0u) ? 1u : 0u; mine = (j == x) ? c : mine; }
        if (sum == G) break;
        __builtin_amdgcn_s_sleep(1);
        if ((++sp & 255u) == 0u) { if (xb_ld(&bar[XB_TMO])) break; if (sp > XB_SPIN_CAP) { atomicAdd(&bar[XB_TMO], 1u); break; } }
    }
    nloc = mine > 0u ? mine : 1u; nx = cnt > 0u ? cnt : 1u;
}

__device__ __forceinline__ void xcd_barrier(const XcdBarrier& b) {
    asm volatile("s_waitcnt vmcnt(0)" ::: "memory");
    __syncthreads();
    if (threadIdx.x == 0) {
        unsigned* bar = b.bar;
        __builtin_amdgcn_s_waitcnt(0);
        unsigned nloc = b.st[0], nx = b.st[1];
        if (nloc == 0u) { xcd_barrier_complete(bar, b.x, nloc, nx); b.st[0] = nloc; b.st[1] = nx; }
        const unsigned old = xb_add(&bar[XB_XSUB(b.x)], 1u);
        const unsigned gen = old / nloc;
        if (old + 1u == (gen + 1u) * nloc) {
            __builtin_amdgcn_fence(__ATOMIC_RELEASE, "agent");
            asm volatile("s_waitcnt vmcnt(0)" ::: "memory");
            const unsigned og = xb_add(&bar[XB_TOP], 1u);
            const unsigned tg = og / nx;
            if (og + 1u == (tg + 1u) * nx) xb_add(&bar[XB_TOPGEN], 1u);
            else XB_SPIN(xb_ld(&bar[XB_TOPGEN]) == tg, bar);
            __builtin_amdgcn_fence(__ATOMIC_ACQUIRE, "agent");
            xb_add(&bar[XB_XGEN(b.x)], 1u);
            asm volatile("s_waitcnt vmcnt(0)" ::: "memory");
        } else {
            XB_SPIN(xb_ld(&bar[XB_XGEN(b.x)]) == gen, bar);
            __builtin_amdgcn_fence(__ATOMIC_ACQUIRE, "agent");
            asm volatile("s_waitcnt vmcnt(0)" ::: "memory");
        }
    }
    __syncthreads();
}


template <int ACT  > struct EpiAct {
    static constexpr bool PERM = true, AFTER_DRAIN = false;
    bf16_t* O; int ldc; const float* bias;
    DI void operator()(const f32x4 (&acc)[2][2][4][2], const Unit& u, int wr, int wc, int fr, int fq) const {
        const int row0 = u.pm * 256 + wr * 64 + fr, col0 = u.pn * 256 + wc * 32 + 8 * fq;
        f32x4 bv[2][2];
#pragma unroll
        for (int bj = 0; bj < 2; ++bj)
#pragma unroll
            for (int n = 0; n < 2; ++n) bv[bj][n] = (ACT == 2) ? *(const f32x4*)(bias + col0 + bj * 128 + 4 * n) : (f32x4){0.f, 0.f, 0.f, 0.f};
#pragma unroll
        for (int ai = 0; ai < 2; ++ai)
#pragma unroll
            for (int m = 0; m < 4; ++m) { bf16_t* rowp = O + (size_t)(row0 + ai * 128 + m * 16) * ldc + col0;
#pragma unroll
                for (int bj = 0; bj < 2; ++bj) { f32x4 v0 = acc[ai][bj][m][0] + bv[bj][0], v1 = acc[ai][bj][m][1] + bv[bj][1];
#pragma unroll
                    for (int j = 0; j < 4; ++j) { if (ACT == 1) { v0[j] = relu2(v0[j]); v1[j] = relu2(v1[j]); } if (ACT == 2) { v0[j] = gelu_tanh(v0[j]); v1[j] = gelu_tanh(v1[j]); } }
                    u32x4 w; w.x = pk2(v0[0], v0[1]); w.y = pk2(v0[2], v0[3]); w.z = pk2(v1[0], v1[1]); w.w = pk2(v1[2], v1[3]);
                    *(u32x4*)(rowp + bj * 128) = w; } }
    }
};
struct EpiRope {
    static constexpr bool PERM = true, AFTER_DRAIN = false;
    bf16_t* O; int ldc; const float* cs; const float* sn; int rope_tiles;
    DI void operator()(const f32x4 (&acc)[2][2][4][2], const Unit& u, int wr, int wc, int fr, int fq) const {
        const int row0 = u.pm * 256 + wr * 64 + fr, col0 = u.pn * 256 + wc * 32 + 8 * fq;
        const bool rope = u.pn < rope_tiles; const int i0 = 16 * (wc & 1) + 4 * fq;
#pragma unroll
        for (int ai = 0; ai < 2; ++ai)
#pragma unroll
            for (int m = 0; m < 4; ++m) { const int row = row0 + ai * 128 + m * 16; bf16_t* rowp = O + (size_t)row * ldc + col0;
                f32x4 c4 = {1.f, 1.f, 1.f, 1.f}, s4 = {0.f, 0.f, 0.f, 0.f};
                if (rope) { c4 = *(const f32x4*)(cs + (size_t)row * 32 + i0); s4 = *(const f32x4*)(sn + (size_t)row * 32 + i0); }
#pragma unroll
                for (int bj = 0; bj < 2; ++bj) { const f32x4 v0 = acc[ai][bj][m][0], v1 = acc[ai][bj][m][1];
                    const float a0 = v0[0] * c4[0] - v0[1] * s4[0], b0 = v0[1] * c4[0] + v0[0] * s4[0];
                    const float a1 = v0[2] * c4[1] - v0[3] * s4[1], b1 = v0[3] * c4[1] + v0[2] * s4[1];
                    const float a2 = v1[0] * c4[2] - v1[1] * s4[2], b2 = v1[1] * c4[2] + v1[0] * s4[2];
                    const float a3 = v1[2] * c4[3] - v1[3] * s4[3], b3 = v1[3] * c4[3] + v1[2] * s4[3];
                    u32x4 w; w.x = pk2(a0, b0); w.y = pk2(a1, b1); w.z = pk2(a2, b2); w.w = pk2(a3, b3);
                    *(u32x4*)(rowp + bj * 128) = w; }
                asm volatile("" ::: "memory"); }
    }
};
struct EpiRes {
    static constexpr bool PERM = true, AFTER_DRAIN = false;
    float* X;
    DI void operator()(const f32x4 (&acc)[2][2][4][2], const Unit& u, int wr, int wc, int fr, int fq) const {
        const int row0 = u.pm * 256 + wr * 64 + fr, col0 = u.pn * 256 + wc * 32 + 8 * fq;
#pragma unroll
        for (int ai = 0; ai < 2; ++ai)
#pragma unroll
            for (int m = 0; m < 4; ++m) { float* rowp = X + (size_t)(row0 + ai * 128 + m * 16) * DM + col0;
#pragma unroll
                for (int bj = 0; bj < 2; ++bj) { f32x4 x0 = *(const f32x4*)(rowp + bj * 128), x1 = *(const f32x4*)(rowp + bj * 128 + 4);
                    x0 = x0 * ALPHA + acc[ai][bj][m][0]; x1 = x1 * ALPHA + acc[ai][bj][m][1];
                    *(f32x4*)(rowp + bj * 128) = x0; *(f32x4*)(rowp + bj * 128 + 4) = x1; } }
    }
};
struct EpiVt {
    static constexpr bool PERM = true, AFTER_DRAIN = false;
    bf16_t* O; const float* bias; float* vst;
    DI void operator()(const f32x4 (&acc)[2][2][4][2], const Unit& u, int wr, int wc, int fr, int fq) const {
        const int row0 = u.pm * 256 + wr * 64 + fr, col0 = u.pn * 256 + wc * 32 + 8 * fq;
#pragma unroll
        for (int bj = 0; bj < 2; ++bj) {
            f32x4 s1[2] = {{0.f, 0.f, 0.f, 0.f}, {0.f, 0.f, 0.f, 0.f}}, s2[2] = {{0.f, 0.f, 0.f, 0.f}, {0.f, 0.f, 0.f, 0.f}};
#pragma unroll
            for (int ai = 0; ai < 2; ++ai)
#pragma unroll
                for (int m = 0; m < 4; ++m) { const int row = row0 + ai * 128 + m * 16; const float b = bias[row];
                    f32x4 v0 = acc[ai][bj][m][0] + b, v1 = acc[ai][bj][m][1] + b;
#pragma unroll
                    for (int j = 0; j < 4; ++j) { v0[j] = gelu_tanh(v0[j]); v1[j] = gelu_tanh(v1[j]); }
                    s1[0] += v0; s1[1] += v1; s2[0] += v0 * v0; s2[1] += v1 * v1;
                    u32x4 w; w.x = pk2(v0[0], v0[1]); w.y = pk2(v0[2], v0[3]); w.z = pk2(v1[0], v1[1]); w.w = pk2(v1[2], v1[3]);
                    *(u32x4*)(O + (size_t)row * T + col0 + bj * 128) = w; }
#pragma unroll
            for (int n = 0; n < 2; ++n)
#pragma unroll
                for (int j = 0; j < 4; ++j) { float a = s1[n][j], q = s2[n][j];
#pragma unroll
                    for (int o = 1; o < 16; o <<= 1) { a += __shfl_xor(a, o); q += __shfl_xor(q, o); }
                    if (fr == 0) { const int tok = col0 + bj * 128 + 4 * n + j; *(f32x2_t*)(vst + ((size_t)tok * 16 + u.pm * 2 + wr) * 2) = (f32x2_t){a, q}; } }
        }
    }
};

DI void sincos_acc(float ang, float& s, float& c) {
    const double a = (double)ang;
    const double kq = __builtin_rint(a * 0.63661977236758134308);
    double r = __builtin_fma(-kq, 1.57079632673412561417e+00, a);
    r = __builtin_fma(-kq, 6.07710050650619224932e-11, r);
    const int q = (int)kq & 3;
    const double r2 = r * r;
    const double sp = r + r * r2 * (-1.66666666666666324348e-01 + r2 * (8.33333333332248946124e-03 + r2 * (-1.98412698298579493134e-04 + r2 * (2.75573137070700676789e-06 + r2 * (-2.50507602534068634195e-08 + r2 * 1.58969099521155010221e-10)))));
    const double cp = 1.0 - 0.5 * r2 + r2 * r2 * (4.16666666666666019037e-02 + r2 * (-1.38888888888741095749e-03 + r2 * (2.48015872894767294178e-05 + r2 * (-2.75573143513906633035e-07 + r2 * (2.08757232129817482790e-09 + r2 * -1.13596475577881948265e-11)))));
    const double ss = (q & 1) ? cp : sp, cc = (q & 1) ? sp : cp;
    s = (float)((q & 2) ? -ss : ss);
    c = (float)((q == 1 || q == 2) ? -cc : cc);
}
DI void phase0(const float* x, const int* pos, float* xf, bf16_t* xb, float* cs, float* sn, int gtid, int nth) {
    for (int idx = gtid; idx < T * 32; idx += nth) { const int tok = idx >> 5, i = idx & 31; const float ang = (float)pos[tok] * INVF[i]; float s, c; sincos_acc(ang, s, c); cs[idx] = c; sn[idx] = s; }
    for (int idx = gtid; idx < T * DM / 4; idx += nth) { const f32x4 v = ((const f32x4*)x)[idx]; ((f32x4*)xf)[idx] = v; u32x2 w; w.x = pk2(v[0], v[1]); w.y = pk2(v[2], v[3]); ((u32x2*)xb)[idx] = w; }
}
DI int wmap(int n, int mode) {
    if (mode == 0) return n;
    const int seg = n >> 9, w = n & 511;
    const int base = seg == 0 ? 0 : seg == 1 ? 512 : seg == 2 ? 2560 : seg == 3 ? 2048 : seg == 4 ? 1024 : seg == 5 ? 1536 : 3072;
    const bool rope = (seg == 0) || (seg == 1) || (seg == 4) || (seg == 5);
    if (!rope) return base + w;
    const int hb = w & ~63, d = w & 63;
    return base + hb + 2 * (d & 31) + (d >> 5);
}
DI void wt_item(const float* W, int K, int N, bf16_t* WT, int mode, LAS float* scr, int item, int lane) {
    const int nblk = N / 32, kb = item / nblk, nb = item % nblk, k0 = 64 * kb, n0 = 32 * nb;
#pragma unroll 8
    for (int i = 0; i < 32; ++i) { const int kk = 2 * i + (lane >> 5); scr[kk * 33 + (lane & 31)] = W[(size_t)(k0 + kk) * N + n0 + (lane & 31)]; }
    LDS_WAIT();
    const int c = lane & 7;
#pragma unroll
    for (int j = 0; j < 4; ++j) { const int n = (lane >> 3) + 8 * j; const LAS float* s = scr + (8 * c) * 33 + n;
        u32x4 o; o.x = pk2(s[0 * 33], s[1 * 33]); o.y = pk2(s[2 * 33], s[3 * 33]); o.z = pk2(s[4 * 33], s[5 * 33]); o.w = pk2(s[6 * 33], s[7 * 33]);
        *(u32x4*)(WT + (size_t)wmap(n0 + n, mode) * K + k0 + 8 * c) = o; }
    LDS_WAIT();
}
DI void conv_weights(const float* const* in, int layer, bf16_t* Wb, LAS unsigned char* lds, int gw, int ngw, int wave, int lane) {
    LAS float* scr = (LAS float*)(lds + wave * 16384);
    const int li = layer >> 1;
    const float* w1 = in[14] + (size_t)layer * 1024 * 4096; const float* w2 = in[15] + (size_t)layer * 4096 * 1024;
    if (!(layer & 1)) {
        const float* win = in[4] + (size_t)li * 1024 * 3584; const float* wo = in[6] + (size_t)li * 1024 * 1024;
        constexpr int I_A = 16 * 112, I_O = 16 * 32, I_1 = 16 * 128, I_2 = 64 * 32;
        for (int it = gw; it < I_A + I_O + I_1 + I_2; it += ngw) { int r = it;
            if (r < I_A) { wt_item(win, 1024, 3584, Wb + WE_A, 1, scr, r, lane); continue; } r -= I_A;
            if (r < I_O) { wt_item(wo, 1024, 1024, Wb + WE_O, 0, scr, r, lane); continue; } r -= I_O;
            if (r < I_1) { wt_item(w1, 1024, 4096, Wb + WE_1, 0, scr, r, lane); continue; } r -= I_1;
            wt_item(w2, 4096, 1024, Wb + WE_2, 0, scr, r, lane); }
    } else {
        const float* wuv = in[7] + (size_t)li * 1024 * 4096; const float* wo = in[13] + (size_t)li * 2048 * 1024;
        constexpr int I_A = 16 * 128, I_O = 32 * 32, I_1 = 16 * 128, I_2 = 64 * 32;
        for (int it = gw; it < I_A + I_O + I_1 + I_2; it += ngw) { int r = it;
            if (r < I_A) { wt_item(wuv, 1024, 4096, Wb + WE_A, 0, scr, r, lane); continue; } r -= I_A;
            if (r < I_O) { wt_item(wo, 2048, 1024, Wb + WE_O, 0, scr, r, lane); continue; } r -= I_O;
            if (r < I_1) { wt_item(w1, 1024, 4096, Wb + WE_1, 0, scr, r, lane); continue; } r -= I_1;
            wt_item(w2, 4096, 1024, Wb + WE_2, 0, scr, r, lane); }
    }
}
DI void ln_phase(float* xf, bf16_t* xb, const float* g, const float* b, int gw, int ngw, int lane) {
    for (int m = gw; m < T; m += ngw) {
        f32x4* xr = (f32x4*)(xf + (size_t)m * DM) + lane;
        f32x4 v[4]; float s = 0.f;
#pragma unroll
        for (int j = 0; j < 4; ++j) { v[j] = xr[64 * j]; s += (v[j][0] + v[j][1]) + (v[j][2] + v[j][3]); }
        const float mean = wave_sum(s) * (1.f / DM); float s2 = 0.f;
#pragma unroll
        for (int j = 0; j < 4; ++j) { v[j] = v[j] - mean; s2 += (v[j][0] * v[j][0] + v[j][1] * v[j][1]) + (v[j][2] * v[j][2] + v[j][3] * v[j][3]); }
        const float rstd = 1.f / sqrtf(wave_sum(s2) * (1.f / DM) + LN_EPS);
        u32x2* o8 = (u32x2*)(xb + (size_t)m * DM) + lane;
#pragma unroll
        for (int j = 0; j < 4; ++j) { const f32x4 gg = ((const f32x4*)g)[lane + 64 * j], bb = ((const f32x4*)b)[lane + 64 * j]; const f32x4 o = v[j] * rstd * gg + bb;
            xr[64 * j] = o; u32x2 w; w.x = pk2(o[0], o[1]); w.y = pk2(o[2], o[3]); o8[64 * j] = w; }
    }
}

DI void kmean_phase(const bf16_t* P1, float* KM, int gw, int ngw, int lane) {
    for (int u = gw; u < 1024; u += ngw) {
        const int bh = u >> 5, j = u & 31, b = bh >> 3, h = bh & 7, c8 = lane & 7, rg = lane >> 3;
        const bf16_t* p = P1 + (size_t)(b * SEQ + j * 256 + rg) * P1C + OFF_KB + h * 64 + c8 * 8;
        float a[8];
#pragma unroll
        for (int e = 0; e < 8; ++e) a[e] = 0.f;
        for (int it = 0; it < 32; ++it) { const u32x4 w = *(const u32x4*)(p + (size_t)it * 8 * P1C);
            a[0] += bflo(w.x); a[1] += bfhi(w.x); a[2] += bflo(w.y); a[3] += bfhi(w.y); a[4] += bflo(w.z); a[5] += bfhi(w.z); a[6] += bflo(w.w); a[7] += bfhi(w.w); }
#pragma unroll
        for (int e = 0; e < 8; ++e) { a[e] += __shfl_xor(a[e], 8); a[e] += __shfl_xor(a[e], 16); a[e] += __shfl_xor(a[e], 32); }
        if (rg == 0) { float* o = KM + (size_t)u * 64 + c8 * 8;
            *(f32x4*)o = (f32x4){a[0], a[1], a[2], a[3]} * (1.f / 256.f); *(f32x4*)(o + 4) = (f32x4){a[4], a[5], a[6], a[7]} * (1.f / 256.f); }
    }
}
DI int lst_off(int j) { return 8192 * j - 128 * j * (j + 1); }
DI void gate_phase(const bf16_t* P1, const float* KM, unsigned* cnt, unsigned short* lst, int gw, int ngw, int lane) {
    for (int u = gw; u < 4096; u += ngw) {
        const int bh = u >> 7, qc = u & 127, own = qc >> 2;
        if (own == 0) continue;
        const int b = bh >> 3, h = bh & 7, ql = qc * 64 + lane;
        const bf16_t* qp = P1 + (size_t)(b * SEQ + ql) * P1C + OFF_QB + h * 64;
        float qf[64];
#pragma unroll
        for (int c = 0; c < 8; ++c) { const u32x4 w = *(const u32x4*)(qp + 8 * c);
            qf[8 * c + 0] = bflo(w.x); qf[8 * c + 1] = bfhi(w.x); qf[8 * c + 2] = bflo(w.y); qf[8 * c + 3] = bfhi(w.y); qf[8 * c + 4] = bflo(w.z); qf[8 * c + 5] = bfhi(w.z); qf[8 * c + 6] = bflo(w.w); qf[8 * c + 7] = bfhi(w.w); }
        float v0 = -INFINITY, v1 = -INFINITY, v2 = -INFINITY; int i0 = 0, i1 = 0, i2 = 0;
        const float* km = KM + (size_t)bh * 32 * 64;
        for (int j = 0; j < own; ++j) { float g = 0.f;
#pragma unroll
            for (int d = 0; d < 64; ++d) g += qf[d] * km[j * 64 + d];
            if (g > v0) { v2 = v1; i2 = i1; v1 = v0; i1 = i0; v0 = g; i0 = j; } else if (g > v1) { v2 = v1; i2 = i1; v1 = g; i1 = j; } else if (g > v2) { v2 = g; i2 = j; } }
        const int nsel = own < 3 ? own : 3;
#pragma unroll
        for (int s = 0; s < 3; ++s) if (s < nsel) { const int j = s == 0 ? i0 : s == 1 ? i1 : i2;
            const unsigned p = atomicAdd(&cnt[bh * 32 + j], 1u);
            lst[(size_t)bh * LCAP + lst_off(j) + p] = (unsigned short)(ql | (s << 13)); }
    }
}
DI void moba_phase(const bf16_t* P1, const bf16_t* VT, const unsigned* cnt, const unsigned short* lst, bf16_t* PO, float* PML, LAS unsigned char* lds, int tid, int wave, int lane) {
    LAS int* pref = (LAS int*)(lds + 73728); LAS int* ntl = (LAS int*)(lds + 77824); LAS int* totw = (LAS int*)(lds + 81920);
    for (int p = tid; p < 1024; p += 512) { int v = 0; if (p < 992) { const int bh = p / 31, j = p % 31; v = (int)((cnt[bh * 32 + j] + 127u) >> 7); } ntl[p] = v; }
    __syncthreads();
    if (wave == 0) { const int base = lane * 16; int s = 0;
#pragma unroll
        for (int k = 0; k < 16; ++k) s += ntl[base + k];
        int incl = s;
#pragma unroll
        for (int o = 1; o < 64; o <<= 1) { const int t = __shfl_up(incl, o); if (lane >= o) incl += t; }
        int run = incl - s;
#pragma unroll
        for (int k = 0; k < 16; ++k) { pref[base + k] = run; run += ntl[base + k]; }
        if (lane == 63) totw[0] = incl; }
    __syncthreads();
    const int total_sel = totw[0], total = total_sel + 2048;
    const int r = lane & 15, q = lane >> 4;
    for (int it = blockIdx.x; it < total; it += gridDim.x) {
        int bh, blk, t, cntv; bool ownit;
        if (it < total_sel) { int lo = 0, hi = 991; while (lo < hi) { const int mid = (lo + hi + 1) >> 1; if (pref[mid] <= it) lo = mid; else hi = mid - 1; }
            bh = lo / 31; blk = lo % 31; t = it - pref[lo]; cntv = (int)cnt[bh * 32 + blk]; ownit = false; }
        else { const int o = it - total_sel; bh = o >> 6; t = o & 63; blk = t >> 1; cntv = 0; ownit = true; }
        const int b = bh >> 3, h = bh & 7; const size_t tokb = (size_t)b * SEQ + blk * 256;
#pragma unroll
        for (int i = 0; i < 4; ++i) { const int c = tid + 512 * i, row = c >> 3, cc = c & 7;
            *(LAS u32x4*)(lds + row * 144 + cc * 16) = *(const u32x4*)(P1 + (tokb + row) * P1C + OFF_KB + h * 64 + cc * 8); }
#pragma unroll
        for (int i = 0; i < 4; ++i) { const int c = tid + 512 * i, row = c >> 5, cc = c & 31;
            *(LAS u32x4*)(lds + 36864 + row * 528 + cc * 16) = *(const u32x4*)(VT + (size_t)(512 + h * 64 + row) * T + tokb + cc * 8); }
        __syncthreads();
        const int qi = wave * 16 + r; int ql, slot; bool valid;
        if (ownit) { ql = t * 128 + qi; slot = 3; valid = true; }
        else { const int li = t * 128 + qi; valid = li < cntv; const unsigned e = lst[(size_t)bh * LCAP + lst_off(blk) + (valid ? li : 0)]; ql = (int)(e & 8191u); slot = (int)(e >> 13); }
        const size_t tokq = (size_t)b * SEQ + ql;
        bf16x8 bq[2];
#pragma unroll
        for (int ks = 0; ks < 2; ++ks) bq[ks] = *(const bf16x8*)(P1 + tokq * P1C + OFF_QB + h * 64 + ks * 32 + q * 8);
        f32x4 st[16];
#pragma unroll
        for (int kt = 0; kt < 16; ++kt) { f32x4 a = {0.f, 0.f, 0.f, 0.f};
#pragma unroll
            for (int ks = 0; ks < 2; ++ks) { const bf16x8 ka = *(const LAS bf16x8*)(lds + (16 * kt + r) * 144 + ks * 64 + q * 16); a = mfma16(ka, bq[ks], a); }
            st[kt] = a; }
        const float SC = 0.125f * 1.4426950408889634f; const int pq = ql & 255;
        float m = -INFINITY;
#pragma unroll
        for (int kt = 0; kt < 16; ++kt)
#pragma unroll
            for (int s = 0; s < 4; ++s) { float v = st[kt][s] * SC; if (ownit && (16 * kt + 4 * q + s) > pq) v = -INFINITY; st[kt][s] = v; m = fmaxf(m, v); }
        m = fmaxf(m, __shfl_xor(m, 16)); m = fmaxf(m, __shfl_xor(m, 32));
        float l = 0.f;
#pragma unroll
        for (int kt = 0; kt < 16; ++kt)
#pragma unroll
            for (int s = 0; s < 4; ++s) { const float p = exp2f(st[kt][s] - m); st[kt][s] = p; l += p; }
        l += __shfl_xor(l, 16); l += __shfl_xor(l, 32);
        bf16x8 pf[8];
#pragma unroll
        for (int kk = 0; kk < 8; ++kk) pf[kk] = pack44(st[2 * kk], st[2 * kk + 1]);
        f32x4 o[4];
#pragma unroll
        for (int et = 0; et < 4; ++et) { f32x4 a = {0.f, 0.f, 0.f, 0.f};
#pragma unroll
            for (int kk = 0; kk < 8; ++kk) { const LAS unsigned char* vp = lds + 36864 + (16 * et + r) * 528 + (32 * kk + 4 * q) * 2;
                const u32x2 lo = *(const LAS u32x2*)vp, hi = *(const LAS u32x2*)(vp + 32); const u32x4 w = {lo.x, lo.y, hi.x, hi.y};
                a = mfma16(__builtin_bit_cast(bf16x8, w), pf[kk], a); }
            o[et] = a; }
        if (valid) { const size_t pidx = ((size_t)slot * T + tokq) * 8 + h;
#pragma unroll
            for (int et = 0; et < 4; ++et) { u32x2 w; w.x = pk2(o[et][0], o[et][1]); w.y = pk2(o[et][2], o[et][3]); *(u32x2*)(PO + pidx * 64 + 16 * et + 4 * q) = w; }
            if (q == 0) *(f32x2_t*)(PML + pidx * 2) = (f32x2_t){m, l}; }
        __syncthreads();
    }
}
DI void combine_phase(const bf16_t* PO, const float* PML, bf16_t* Y, int gtid, int nth) {
    for (int idx = gtid; idx < T * 64; idx += nth) {
        const int e8 = idx & 7, th = idx >> 3, tok = th >> 3, h = th & 7;
        const int own = (tok & 8191) >> 8, nsel = own < 3 ? own : 3;
        const f32x2_t ml3 = *(const f32x2_t*)(PML + ((size_t)3 * T * 8 + th) * 2);
        float M = ml3.x, ms[3], ls[3];
#pragma unroll
        for (int s = 0; s < 3; ++s) { ms[s] = -INFINITY; ls[s] = 0.f; if (s < nsel) { const f32x2_t ml = *(const f32x2_t*)(PML + ((size_t)s * T * 8 + th) * 2); ms[s] = ml.x; ls[s] = ml.y; M = fmaxf(M, ml.x); } }
        float acc[8];
        { const float w3 = exp2f(ml3.x - M); const u32x4 w = *(const u32x4*)(PO + ((size_t)3 * T * 8 + th) * 64 + e8 * 8);
          acc[0] = w3 * bflo(w.x); acc[1] = w3 * bfhi(w.x); acc[2] = w3 * bflo(w.y); acc[3] = w3 * bfhi(w.y); acc[4] = w3 * bflo(w.z); acc[5] = w3 * bfhi(w.z); acc[6] = w3 * bflo(w.w); acc[7] = w3 * bfhi(w.w);
          float den = w3 * ml3.y;
#pragma unroll
          for (int s = 0; s < 3; ++s) if (s < nsel) { const float ww = exp2f(ms[s] - M); den += ww * ls[s]; const u32x4 x = *(const u32x4*)(PO + ((size_t)s * T * 8 + th) * 64 + e8 * 8);
              acc[0] += ww * bflo(x.x); acc[1] += ww * bfhi(x.x); acc[2] += ww * bflo(x.y); acc[3] += ww * bfhi(x.y); acc[4] += ww * bflo(x.z); acc[5] += ww * bfhi(x.z); acc[6] += ww * bflo(x.w); acc[7] += ww * bfhi(x.w); }
          const float inv = 1.f / den;
          u32x4 o; o.x = pk2(acc[0] * inv, acc[1] * inv); o.y = pk2(acc[2] * inv, acc[3] * inv); o.z = pk2(acc[4] * inv, acc[5] * inv); o.w = pk2(acc[6] * inv, acc[7] * inv);
          *(u32x4*)(Y + (size_t)tok * DM + 512 + h * 64 + e8 * 8) = o; }
    }
}

DI void retkv_phase(const bf16_t* P1, const bf16_t* VT, float* KV, int gw, int ngw, int lane) {
    const int r = lane & 15, q = lane >> 4;
    for (int u = gw; u < 2048; u += ngw) {
        const int bh = u >> 6, n = u & 63, b = bh >> 3, h = bh & 7; const size_t tok0 = (size_t)b * SEQ + n * 128; const float lg = LGAM[h];
        f32x4 acc[4][4];
#pragma unroll
        for (int et = 0; et < 4; ++et)
#pragma unroll
            for (int dt = 0; dt < 4; ++dt) acc[et][dt] = (f32x4){0.f, 0.f, 0.f, 0.f};
#pragma unroll 1
        for (int ks = 0; ks < 4; ++ks) {
            bf16x8 af[4], bfr[4];
#pragma unroll
            for (int et = 0; et < 4; ++et) af[et] = *(const bf16x8*)(VT + (size_t)(h * 64 + 16 * et + r) * T + tok0 + 32 * ks + 8 * q);
            float z[8];
#pragma unroll
            for (int i = 0; i < 8; ++i) z[i] = expf(lg * (float)(127 - (32 * ks + 8 * q + i)));
#pragma unroll
            for (int dt = 0; dt < 4; ++dt) { const bf16_t* kp = P1 + (tok0 + 32 * ks + 8 * q) * P1C + OFF_KA + h * 64 + 16 * dt + r; float f[8];
#pragma unroll
                for (int i = 0; i < 8; ++i) f[i] = bf2f(kp[(size_t)i * P1C]) * z[i];
                bfr[dt] = pack8(f[0], f[1], f[2], f[3], f[4], f[5], f[6], f[7]); }
#pragma unroll
            for (int et = 0; et < 4; ++et)
#pragma unroll
                for (int dt = 0; dt < 4; ++dt) acc[et][dt] = mfma16(af[et], bfr[dt], acc[et][dt]);
        }
        float* o = KV + (size_t)u * 4096;
#pragma unroll
        for (int et = 0; et < 4; ++et)
#pragma unroll
            for (int dt = 0; dt < 4; ++dt)
#pragma unroll
                for (int s = 0; s < 4; ++s) o[(16 * et + 4 * q + s) * 64 + 16 * dt + r] = acc[et][dt][s] * 0.125f;
    }
}
DI void scan_phase(float* KV, int gtid, int nth) {
    for (int idx = gtid; idx < 32 * 4096; idx += nth) { const int bh = idx >> 12, el = idx & 4095, h = bh & 7; const float cd = expf(LGAM[h] * 128.f);
        float st = 0.f; float* p = KV + (size_t)bh * 64 * 4096 + el;
        for (int n = 0; n < 64; ++n) { const float t = p[(size_t)n * 4096]; p[(size_t)n * 4096] = st; st = st * cd + t; } }
}
DI void retout_phase(const bf16_t* P1, const bf16_t* VT, const float* KV, const float* gn, bf16_t* Y, int gw, int ngw, int lane) {
    const int r = lane & 15, q = lane >> 4;
    for (int u = gw; u < 2048; u += ngw) {
        const int bh = u >> 6, n = u & 63, b = bh >> 3, h = bh & 7; const size_t tok0 = (size_t)b * SEQ + n * 128; const float lg = LGAM[h];
        const float* St = KV + (size_t)u * 4096;
        bf16x8 sa[4][2];
#pragma unroll
        for (int et = 0; et < 4; ++et)
#pragma unroll
            for (int ks = 0; ks < 2; ++ks) { const float* p = St + (16 * et + r) * 64 + ks * 32 + q * 8; sa[et][ks] = pack44(*(const f32x4*)p, *(const f32x4*)(p + 4)); }
#pragma unroll 1
        for (int it = 0; it < 8; ++it) {
            const size_t tq = tok0 + 16 * it + r; const int iq = 16 * it + r;
            bf16x8 bq[2];
#pragma unroll
            for (int ks = 0; ks < 2; ++ks) bq[ks] = *(const bf16x8*)(P1 + tq * P1C + OFF_QA + h * 64 + ks * 32 + q * 8);
            f32x4 st[8];
#pragma unroll
            for (int jt = 0; jt < 8; ++jt) { f32x4 a = {0.f, 0.f, 0.f, 0.f};
                if (jt <= it) {
#pragma unroll
                    for (int ks = 0; ks < 2; ++ks) { const bf16x8 ka = *(const bf16x8*)(P1 + (tok0 + 16 * jt + r) * P1C + OFF_KA + h * 64 + ks * 32 + q * 8); a = mfma16(ka, bq[ks], a); }
#pragma unroll
                    for (int s = 0; s < 4; ++s) { const int df = iq - (16 * jt + 4 * q + s); a[s] = df >= 0 ? a[s] * 0.125f * expf(lg * (float)df) : 0.f; } }
                st[jt] = a; }
            f32x4 oi[4], oc[4];
#pragma unroll
            for (int et = 0; et < 4; ++et) { f32x4 a = {0.f, 0.f, 0.f, 0.f};
#pragma unroll
                for (int kk = 0; kk < 4; ++kk) if (2 * kk <= it) { const bf16_t* vp = VT + (size_t)(h * 64 + 16 * et + r) * T + tok0 + 32 * kk + 4 * q;
                    const u32x2 lo = *(const u32x2*)vp, hi = *(const u32x2*)(vp + 16); const u32x4 w = {lo.x, lo.y, hi.x, hi.y};
                    a = mfma16(__builtin_bit_cast(bf16x8, w), pack44(st[2 * kk], st[2 * kk + 1]), a); }
                oi[et] = a;
                f32x4 c = {0.f, 0.f, 0.f, 0.f};
#pragma unroll
                for (int ks = 0; ks < 2; ++ks) c = mfma16(sa[et][ks], bq[ks], c);
                oc[et] = c; }
            const float xi = expf(lg * (float)(iq + 1));
            float sum = 0.f;
#pragma unroll
            for (int et = 0; et < 4; ++et) { oi[et] = oi[et] + oc[et] * xi; sum += (oi[et][0] + oi[et][1]) + (oi[et][2] + oi[et][3]); }
            sum += __shfl_xor(sum, 16); sum += __shfl_xor(sum, 32);
            const float mu = sum * (1.f / 64.f); float sq = 0.f;
#pragma unroll
            for (int et = 0; et < 4; ++et) { oi[et] = oi[et] - mu; sq += (oi[et][0] * oi[et][0] + oi[et][1] * oi[et][1]) + (oi[et][2] * oi[et][2] + oi[et][3] * oi[et][3]); }
            sq += __shfl_xor(sq, 16); sq += __shfl_xor(sq, 32);
            const float rstd = 1.f / sqrtf(sq * (1.f / 64.f) + LN_EPS);
#pragma unroll
            for (int et = 0; et < 4; ++et) { const int e0 = h * 64 + 16 * et + 4 * q;
                const u32x2 gw2 = *(const u32x2*)(P1 + tq * P1C + OFF_GA + e0); const f32x4 gg = *(const f32x4*)(gn + e0);
                const float g0 = bflo(gw2.x), g1 = bfhi(gw2.x), g2 = bflo(gw2.y), g3 = bfhi(gw2.y);
                const float y0 = oi[et][0] * rstd * gg[0] * silu(g0), y1 = oi[et][1] * rstd * gg[1] * silu(g1), y2 = oi[et][2] * rstd * gg[2] * silu(g2), y3 = oi[et][3] * rstd * gg[3] * silu(g3);
                u32x2 w; w.x = pk2(y0, y1); w.y = pk2(y2, y3); *(u32x2*)(Y + tq * DM + e0) = w; }
        }
    }
}

DI void sgu_phase(const bf16_t* VT2, const bf16_t* HU, const float* VST, const float* wsl, const float* bsl, const float* lng, const float* lnb, bf16_t* SG, LAS unsigned char* lds, int gw, int ngw, int wave, int lane) {
    const int r = lane & 15, q = lane >> 4;
    LAS f32x2_t* stl = (LAS f32x2_t*)(lds + wave * 1024);
    for (int u = gw; u < 2048; u += ngw) {
        const int c = u >> 3, g = u & 7; const size_t tok0 = (size_t)c * 128;
#pragma unroll
        for (int tt = 0; tt < 2; ++tt) { const int tk = lane + 64 * tt; const f32x4* p = (const f32x4*)(VST + (tok0 + tk) * 32); float S = 0.f, Q = 0.f;
#pragma unroll
            for (int k = 0; k < 8; ++k) { const f32x4 v = p[k]; S += v[0] + v[2]; Q += v[1] + v[3]; }
            const float mean = S * (1.f / 2048.f), var = Q * (1.f / 2048.f) - mean * mean;
            stl[tk] = (f32x2_t){mean, 1.f / sqrtf(var + LN_EPS)}; }
        LDS_WAIT();
        const float* wsg = wsl + (size_t)g * 128 * 128;
        bf16x8 wf[8][4];
#pragma unroll
        for (int it = 0; it < 8; ++it)
#pragma unroll
            for (int ks = 0; ks < 4; ++ks) if (ks <= (it >> 1)) { const int i = 16 * it + r, j0 = 32 * ks + 8 * q; const float* p = wsg + (size_t)i * 128 + j0;
                const f32x4 a = *(const f32x4*)p, bb = *(const f32x4*)(p + 4); float f[8];
#pragma unroll
                for (int jj = 0; jj < 4; ++jj) { f[jj] = (j0 + jj <= i) ? a[jj] : 0.f; f[4 + jj] = (j0 + 4 + jj <= i) ? bb[jj] : 0.f; }
                wf[it][ks] = pack8(f[0], f[1], f[2], f[3], f[4], f[5], f[6], f[7]); }
        for (int ct = 0; ct < 16; ++ct) {
            const int f = g * 256 + 16 * ct + r; const float gain = lng[f], bias = lnb[f];
            bf16x8 af[4];
#pragma unroll
            for (int ks = 0; ks < 4; ++ks) { const u32x4 w = *(const u32x4*)(VT2 + (size_t)f * T + tok0 + 32 * ks + 8 * q); const LAS f32x4* sp = (const LAS f32x4*)(stl + 32 * ks + 8 * q);
                const f32x4 s0 = sp[0], s1 = sp[1], s2 = sp[2], s3 = sp[3];
                af[ks] = pack8((bflo(w.x) - s0[0]) * s0[1] * gain + bias, (bfhi(w.x) - s0[2]) * s0[3] * gain + bias, (bflo(w.y) - s1[0]) * s1[1] * gain + bias, (bfhi(w.y) - s1[2]) * s1[3] * gain + bias,
                               (bflo(w.z) - s2[0]) * s2[1] * gain + bias, (bfhi(w.z) - s2[2]) * s2[3] * gain + bias, (bflo(w.w) - s3[0]) * s3[1] * gain + bias, (bfhi(w.w) - s3[2]) * s3[3] * gain + bias); }
#pragma unroll
            for (int it = 0; it < 8; ++it) { f32x4 a = {0.f, 0.f, 0.f, 0.f};
#pragma unroll
                for (int ks = 0; ks < 4; ++ks) if (ks <= (it >> 1)) a = mfma16(af[ks], wf[it][ks], a);
                const size_t tok = tok0 + 16 * it + r; const int feat = g * 256 + 16 * ct + 4 * q; const float bsi = bsl[g * 128 + 16 * it + r];
                const u32x2 uu = *(const u32x2*)(HU + tok * 2048 + feat);
                u32x2 w; w.x = pk2((a[0] + bsi) * bflo(uu.x), (a[1] + bsi) * bfhi(uu.x)); w.y = pk2((a[2] + bsi) * bflo(uu.y), (a[3] + bsi) * bfhi(uu.y));
                *(u32x2*)(SG + tok * 2048 + feat) = w; }
        }
        LDS_WAIT();
    }
}

struct Args { const float* in[16]; float* out; unsigned char* ws; int ph_lo, ph_hi; };
__global__ void __launch_bounds__(512, 2) mega_fwd(Args args) {
    extern __shared__ __attribute__((aligned(16))) unsigned char lds_raw[];
    LAS unsigned char* lds = (LAS unsigned char*)lds_raw;
    cg::grid_group grid = cg::this_grid();
    const int G = gridDim.x, bx = blockIdx.x, ngw = G * 8, nth = G * 512;
    const int lo = args.ph_lo, hi = args.ph_hi;
#define xf (args.out)
#define cnt ((unsigned*)(args.ws + WS_CTL))
#define Wb ((bf16_t*)(args.ws + WS_W))
#define cs ((float*)(args.ws + WS_CS))
#define sn ((float*)(args.ws + WS_SN))
#define xb ((bf16_t*)(args.ws + WS_XB))
#define P1 ((bf16_t*)(args.ws + WS_P1))
#define VT ((bf16_t*)(args.ws + WS_VT))
#define PO ((bf16_t*)(args.ws + WS_PO))
#define PML ((float*)(args.ws + WS_PML))
#define KV ((float*)(args.ws + WS_KV))
#define lst ((unsigned short*)(args.ws + WS_LST))
#define KM ((float*)(args.ws + WS_KM))
#define HB ((bf16_t*)(args.ws + WS_H))
#define HU ((bf16_t*)(args.ws + WS_HU))
#define VT2 ((bf16_t*)(args.ws + WS_VT2))
#define SG ((bf16_t*)(args.ws + WS_SG))
#define VST ((float*)(args.ws + WS_VST))
#define Y xb
    { volatile LAS unsigned* misc0 = (volatile LAS unsigned*)(lds + 143360); if (threadIdx.x < 2) misc0[threadIdx.x] = 0u; }
    __syncthreads();
    XcdBarrier bar; bar.bar = (unsigned*)(args.ws + WS_BAR); bar.x = 0; bar.st = nullptr;
    if (hi - lo > 1) bar = xcd_barrier_post((unsigned*)(args.ws + WS_BAR), (volatile LAS unsigned*)(lds + 143360));
    int ph = 0;
#define PH_BEGIN if (ph >= lo && ph < hi) { int tid = threadIdx.x; asm volatile("" : "+v"(tid)); const int lane = tid & 63, wave = __builtin_amdgcn_readfirstlane(tid >> 6), gw = bx * 8 + wave, gtid = bx * 512 + tid; (void)lane; (void)gw; (void)gtid;
#define PH_END   if (ph + 1 < hi) { if (ph == 0) grid.sync(); else xcd_barrier(bar); for (int s_ = 0; s_ < XSYNC; ++s_) xcd_barrier(bar); } } ++ph;
#define GEMM(EPI, g_, S_, E_) pg8::gemm_phase<EPI, pg8::StaticOrder, true, true>(lds, g_, S_, E_)

    PH_BEGIN
        RP(0) phase0(args.in[0], (const int*)args.in[1], xf, xb, cs, sn, gtid, nth);
        RP(0) conv_weights(args.in, 0, Wb, lds, gw, ngw, wave, lane);
    PH_END
    for (int layer = 0; layer < 4; ++layer) {
        const int li = layer >> 1; const bool even = !(layer & 1);
        if (even) {
            PH_BEGIN
                if (bx == 0) for (int i = tid; i < 1024; i += 512) cnt[i] = 0u;
                RP(1) { pg8::Gemm g{xb, Wb + WE_A, T, 2560, 1024}; pg8::StaticOrder S; S.init(T, 2560, G, bx); EpiRope E{P1, P1C, cs, sn, 8}; GEMM(EpiRope, g, S, E); }
                RP(2) { pg8::Gemm g{Wb + WE_A + (size_t)2560 * 1024, xb, 1024, T, 1024}; pg8::StaticOrder S; S.init(1024, T, G, bx); EpiAct<0> E{VT, T, nullptr}; GEMM(EpiAct<0>, g, S, E); }
            PH_END
            PH_BEGIN
                RP(3) kmean_phase(P1, KM, gw, ngw, lane);
                RP(4) retkv_phase(P1, VT, KV, gw, ngw, lane);
            PH_END
            PH_BEGIN
                RP(5) gate_phase(P1, KM, cnt, lst, gw, ngw, lane);
                RP(6) scan_phase(KV, gtid, nth);
            PH_END
            PH_BEGIN
                RP(7) moba_phase(P1, VT, cnt, lst, PO, PML, lds, tid, wave, lane);
            PH_END
            PH_BEGIN
                RP(8) combine_phase(PO, PML, Y, gtid, nth);
                RP(9) retout_phase(P1, VT, KV, args.in[5] + (size_t)li * 512, Y, gw, ngw, lane);
            PH_END
        } else {
            PH_BEGIN
                RP(10) { pg8::Gemm g{xb, Wb + WE_A, T, 2048, 1024}; pg8::StaticOrder S; S.init(T, 2048, G, bx); EpiAct<2> E{HU, 2048, args.in[8] + (size_t)li * 4096}; GEMM(EpiAct<2>, g, S, E); }
                RP(11) { pg8::Gemm g{Wb + WE_A + (size_t)2048 * 1024, xb, 2048, T, 1024}; pg8::StaticOrder S; S.init(2048, T, G, bx); EpiVt E{VT2, args.in[8] + (size_t)li * 4096 + 2048, VST}; GEMM(EpiVt, g, S, E); }
            PH_END
            PH_BEGIN
                RP(12) sgu_phase(VT2, HU, VST, args.in[11] + (size_t)li * 8 * 128 * 128, args.in[12] + (size_t)li * 8 * 128, args.in[9] + (size_t)li * 2048, args.in[10] + (size_t)li * 2048, SG, lds, gw, ngw, wave, lane);
            PH_END
        }
        PH_BEGIN
            RP(13) { pg8::Gemm g{even ? Y : SG, Wb + WE_O, T, 1024, even ? 1024 : 2048}; pg8::StaticOrder S; S.init(T, 1024, G, bx); EpiRes E{xf}; GEMM(EpiRes, g, S, E); }
        PH_END
        PH_BEGIN
            RP(14) ln_phase(xf, xb, args.in[2] + (size_t)(layer * 2 + 0) * DM, args.in[3] + (size_t)(layer * 2 + 0) * DM, gw, ngw, lane);
        PH_END
        PH_BEGIN
            RP(15) { pg8::Gemm g{xb, Wb + WE_1, T, 4096, 1024}; pg8::StaticOrder S; S.init(T, 4096, G, bx); EpiAct<1> E{HB, 4096, nullptr}; GEMM(EpiAct<1>, g, S, E); }
        PH_END
        PH_BEGIN
            RP(16) { pg8::Gemm g{HB, Wb + WE_2, T, 1024, 4096}; pg8::StaticOrder S; S.init(T, 1024, G, bx); EpiRes E{xf}; GEMM(EpiRes, g, S, E); }
        PH_END
        PH_BEGIN
            RP(14) ln_phase(xf, xb, args.in[2] + (size_t)(layer * 2 + 1) * DM, args.in[3] + (size_t)(layer * 2 + 1) * DM, gw, ngw, lane);
            if (layer < 3) RP(0) conv_weights(args.in, layer + 1, Wb, lds, gw, ngw, wave, lane);
        PH_END
    }
}

extern "C" void kernel_launch(void* const* d_in, const int* in_sizes, int n_in, void* d_out, int out_size, void* d_ws, size_t ws_size, hipStream_t stream) {
    static int grid = 0;
    if (grid == 0) {
        if (n_in != 16 || out_size != T * DM || ws_size < WS_NEED) { fprintf(stderr, "kernel_launch: unexpected shapes (n_in %d, out %d, ws %zu)\n", n_in, out_size, ws_size); grid = -1; return; }
        int dev = 0, cus = 0, per_cu = 0;
        if (hipGetDevice(&dev) != hipSuccess || hipDeviceGetAttribute(&cus, hipDeviceAttributeMultiprocessorCount, dev) != hipSuccess) { grid = -1; return; }
        if (hipFuncSetAttribute((const void*)mega_fwd, hipFuncAttributeMaxDynamicSharedMemorySize, LDS_BYTES) != hipSuccess) { fprintf(stderr, "kernel_launch: hipFuncSetAttribute failed\n"); grid = -1; return; }
        if (hipOccupancyMaxActiveBlocksPerMultiprocessor(&per_cu, (const void*)mega_fwd, 512, LDS_BYTES) != hipSuccess || per_cu < 1) per_cu = 1;
        (void)hipGetLastError();
        grid = cus * per_cu;
        fprintf(stderr, "kernel_launch: grid %d (%d CUs x %d)\n", grid, cus, per_cu);
    }
    if (grid < 0) return;
    Args a{};
    for (int i = 0; i < 16; ++i) a.in[i] = (const float*)d_in[i];
    a.out = (float*)d_out; a.ws = (unsigned char*)d_ws;
#if MK_MULTI
    for (int p = 0; p < N_PHASES; ++p) { a.ph_lo = p; a.ph_hi = p + 1; hipLaunchKernelGGL(mega_fwd, dim3(grid), dim3(512), LDS_BYTES, stream, a); }
#else
    a.ph_lo = 0; a.ph_hi = N_PHASES;
    if (hipMemsetAsync((char*)d_ws + WS_BAR, 0, BAR_BYTES, stream) != hipSuccess) { fprintf(stderr, "kernel_launch: memset failed\n"); return; }
    void* params[] = {&a};
    const hipError_t e = hipLaunchCooperativeKernel((const void*)mega_fwd, dim3(grid), dim3(512), params, LDS_BYTES, stream);
    if (e != hipSuccess) fprintf(stderr, "kernel_launch: cooperative launch failed: %s (grid %d)\n", hipGetErrorString(e), grid);
#endif
}
```
